# Optimizing an MI355X kernel written in HIP

```python
import math
import jax, jax.numpy as jnp
from jax import lax
import numpy as np

D_MODEL = 2048
BATCH = 1
SEQ = 16384
DEPTH = 2

MIX_WIDTH = D_MODEL
POOL_WIDTH = D_MODEL // 4
POOL_WINDOWS = (2, 4, 8, 16)
POOL_GROUP = POOL_WIDTH // len(POOL_WINDOWS)
LRU_WIDTH = D_MODEL // 4
LRU_HEADS = 8
LRU_HEAD_DIM = LRU_WIDTH // LRU_HEADS
LRU_CONV = 4
LRU_C = 8.0
ATTN_WIDTH = D_MODEL // 2
ATTN_HEAD_DIM = 64
ATTN_HEADS = ATTN_WIDTH // ATTN_HEAD_DIM
ATTN_BRANCHES = ((128, 1), (512, 4), (2048, 16))
ATTN_BLOCK = 128
D_FF = 5632
IN_WIDTH = POOL_WIDTH + 2 * LRU_WIDTH + 3 * ATTN_WIDTH
IN_SPLITS = (POOL_WIDTH, POOL_WIDTH + LRU_WIDTH, POOL_WIDTH + 2 * LRU_WIDTH,
             POOL_WIDTH + 2 * LRU_WIDTH + ATTN_WIDTH,
             POOL_WIDTH + 2 * LRU_WIDTH + 2 * ATTN_WIDTH)
NORM_EPS = 1e-6
NEG_INF = -1e30

kernel_name = 'hybrid_pool_rglru_dilated_attn_block'


def rms_norm(x, g):
    xf = x.astype(jnp.float32)
    y = xf * lax.rsqrt(jnp.mean(xf * xf, axis=-1, keepdims=True) + NORM_EPS)
    return (y * g.astype(jnp.float32)).astype(x.dtype)


def swiglu(x, w_in, w_out):
    gate, up = jnp.split(x @ w_in, 2, axis=-1)
    return (jax.nn.silu(gate) * up) @ w_out


def alibi_slopes(n_heads):
    return jnp.asarray(2.0 ** (-8.0 * np.arange(1, n_heads + 1) / n_heads), dtype=jnp.float32)


def pool_mixer(u, w, scale):
    b, s, _ = u.shape
    uf = u.astype(jnp.float32).reshape(b, s, len(POOL_WINDOWS), POOL_GROUP)
    cs = jnp.cumsum(uf, axis=1)
    pos = jnp.arange(1, s + 1, dtype=jnp.float32)
    means = []
    for gi, win in enumerate(POOL_WINDOWS):
        c = cs[:, :, gi]
        lag = jnp.pad(c, ((0, 0), (win, 0), (0, 0)))[:, :s]
        means.append((c - lag) / jnp.minimum(pos, float(win))[:, None])
    pooled = jnp.stack(means, axis=2) - uf
    y = jnp.einsum('bsgc,gcd->bsgd', pooled, w.astype(jnp.float32))
    y = y.reshape(b, s, POOL_WIDTH) * scale.astype(jnp.float32)
    return y.astype(u.dtype)


def _lru_combine(left, right):
    a1, b1 = left
    a2, b2 = right
    return a1 * a2, a2 * b1 + b2


def rg_lru_mixer(xb, gate_in, conv_w, conv_b, gate_w, gate_b, lam):
    b, s, c = xb.shape
    xc = lax.conv_general_dilated(
        xb, conv_w[:, None, :], window_strides=(1,), padding=((LRU_CONV - 1, 0),),
        dimension_numbers=('NWC', 'WIO', 'NWC'), feature_group_count=c) + conv_b
    xh = xc.reshape(b, s, LRU_HEADS, LRU_HEAD_DIM)
    g = jnp.einsum('bshc,ghcd->gbshd', xh, gate_w) + gate_b[:, None, None]
    r = jax.nn.sigmoid(g[0].astype(jnp.float32)).reshape(b, s, c)
    i = jax.nn.sigmoid(g[1].astype(jnp.float32)).reshape(b, s, c)
    log_a = -LRU_C * r * jax.nn.softplus(-lam.astype(jnp.float32))
    a = jnp.exp(log_a)
    u = jnp.sqrt(-jnp.expm1(2.0 * log_a)) * (i * xc.astype(jnp.float32))
    _, h = lax.associative_scan(_lru_combine, (a, u), axis=1)
    y = h * jax.nn.gelu(gate_in.astype(jnp.float32))
    return y.astype(xb.dtype)


def _dilated_branch(q, k, v, window, dilation, slopes):
    b, s, h, dh = q.shape
    span = window // dilation
    unit = dilation * ATTN_BLOCK
    s_pad = -(-s // unit) * unit
    n_sub = s_pad // dilation
    nb = n_sub // ATTN_BLOCK
    pad = ((0, 0), (0, s_pad - s), (0, 0), (0, 0))

    def to_blocks(t):
        t = jnp.pad(t, pad).reshape(b, n_sub, dilation, h, dh)
        t = jnp.transpose(t, (0, 2, 1, 3, 4))
        return t.reshape(b, dilation, nb, ATTN_BLOCK, h, dh)

    def with_prev(t):
        prev = jnp.pad(t, ((0, 0), (0, 0), (1, 0), (0, 0), (0, 0), (0, 0)))[:, :, :-1]
        return jnp.concatenate([prev, t], axis=3)

    qb = to_blocks(q)
    kb = with_prev(to_blocks(k))
    vb = with_prev(to_blocks(v)).astype(jnp.float32)
    scores = jnp.einsum('brnqhc,brnkhc->brnhqk', qb, kb).astype(jnp.float32)
    qi = jnp.arange(ATTN_BLOCK)[:, None]
    ki = jnp.arange(2 * ATTN_BLOCK)[None, :]
    dist = qi + ATTN_BLOCK - ki
    first = (jnp.arange(nb) == 0)[:, None, None] & (ki < ATTN_BLOCK)[None]
    valid = ((dist >= 0) & (dist <= span))[None] & ~first
    bias = -slopes[:, None, None] * (dist * dilation).astype(jnp.float32)[None]
    scores = jnp.where(valid[None, None, :, None], scores + bias, NEG_INF)
    m = jnp.max(scores, axis=-1)
    p = jnp.exp(scores - m[..., None])
    l = jnp.sum(p, axis=-1)
    m = jnp.transpose(m, (0, 1, 2, 4, 3))
    l = jnp.transpose(l, (0, 1, 2, 4, 3))
    o = jnp.einsum('brnhqk,brnkhc->brnqhc', p, vb) / l[..., None]

    def from_blocks(t):
        tail = t.shape[5:]
        t = t.reshape((b, dilation, n_sub, h) + tail)
        t = jnp.moveaxis(t, 1, 2)
        return t.reshape((b, s_pad, h) + tail)[:, :s]

    return from_blocks(o), from_blocks(m), from_blocks(l)


def dilated_attention(q, k, v):
    slopes = alibi_slopes(q.shape[2])
    outs, ms, ls = [], [], []
    for window, dilation in ATTN_BRANCHES:
        o, m, l = _dilated_branch(q, k, v, window, dilation, slopes)
        outs.append(o)
        ms.append(m)
        ls.append(l)
    m_all = jnp.stack(ms)
    wts = jnp.stack(ls) * jnp.exp(m_all - jnp.max(m_all, axis=0, keepdims=True))
    o = jnp.sum(wts[..., None] * jnp.stack(outs), axis=0) / jnp.sum(wts, axis=0)[..., None]
    return o.astype(q.dtype)


def hybrid_mixer(h, w_in, w_out, pool_w, pool_scale, conv_w, conv_b, gate_w, gate_b, lam):
    b, s, _ = h.shape
    z = h @ w_in
    pool_in, lru_x, lru_g, q, k, v = jnp.split(z, IN_SPLITS, axis=-1)
    y_pool = pool_mixer(pool_in, pool_w, pool_scale)
    y_lru = rg_lru_mixer(lru_x, lru_g, conv_w, conv_b, gate_w, gate_b, lam)
    q = q.reshape(b, s, ATTN_HEADS, ATTN_HEAD_DIM) * (ATTN_HEAD_DIM ** -0.5)
    k = k.reshape(b, s, ATTN_HEADS, ATTN_HEAD_DIM)
    v = v.reshape(b, s, ATTN_HEADS, ATTN_HEAD_DIM)
    y_attn = dilated_attention(q, k, v).reshape(b, s, ATTN_WIDTH)
    y = jnp.concatenate([y_pool, y_lru.astype(h.dtype), y_attn.astype(h.dtype)], axis=-1)
    return y @ w_out


def setup_inputs(seed: int = 0) -> dict:
    key = jax.random.key(seed)
    ks = jax.random.split(key, 16)
    f32 = jnp.float32

    def nrm(k, shape, scale):
        return jax.random.normal(k, shape, f32) * scale

    a0 = jax.random.uniform(ks[15], (DEPTH, LRU_WIDTH), f32, 0.9, 0.999)
    p0 = a0 ** (1.0 / LRU_C)
    lam = jnp.log(p0) - jnp.log1p(-p0)
    return {
        'x': nrm(ks[0], (BATCH, SEQ, D_MODEL), 1.0),
        'norm_g': 1.0 + nrm(ks[1], (DEPTH, 6, D_MODEL), 0.1),
        'ffn1_w_in': nrm(ks[2], (DEPTH, D_MODEL, 2 * D_FF), D_MODEL ** -0.5),
        'ffn1_w_out': nrm(ks[3], (DEPTH, D_FF, D_MODEL), D_FF ** -0.5),
        'mix_w_in': nrm(ks[4], (DEPTH, D_MODEL, IN_WIDTH), D_MODEL ** -0.5),
        'mix_w_out': nrm(ks[5], (DEPTH, MIX_WIDTH, D_MODEL), MIX_WIDTH ** -0.5),
        'pool_w': nrm(ks[6], (DEPTH, len(POOL_WINDOWS), POOL_GROUP, POOL_GROUP), POOL_GROUP ** -0.5),
        'pool_scale': 1.0 + nrm(ks[7], (DEPTH, POOL_WIDTH), 0.1),
        'lru_conv_w': nrm(ks[8], (DEPTH, LRU_CONV, LRU_WIDTH), LRU_CONV ** -0.5),
        'lru_conv_b': nrm(ks[9], (DEPTH, LRU_WIDTH), 0.1),
        'lru_gate_w': nrm(ks[10], (DEPTH, 2, LRU_HEADS, LRU_HEAD_DIM, LRU_HEAD_DIM), LRU_HEAD_DIM ** -0.5),
        'lru_gate_b': nrm(ks[11], (DEPTH, 2, LRU_HEADS, LRU_HEAD_DIM), 0.1),
        'lru_lambda': lam,
        'ffn2_w_in': nrm(ks[12], (DEPTH, D_MODEL, 2 * D_FF), D_MODEL ** -0.5),
        'ffn2_w_out': nrm(ks[13], (DEPTH, D_FF, D_MODEL), D_FF ** -0.5),
    }


def reference(x, norm_g, ffn1_w_in, ffn1_w_out, mix_w_in, mix_w_out, pool_w, pool_scale,
              lru_conv_w, lru_conv_b, lru_gate_w, lru_gate_b, lru_lambda, ffn2_w_in, ffn2_w_out):
    for layer in range(DEPTH):
        g = norm_g[layer]
        h = swiglu(rms_norm(x, g[0]), ffn1_w_in[layer], ffn1_w_out[layer])
        x = x + 0.5 * rms_norm(h, g[1])
        h = hybrid_mixer(rms_norm(x, g[2]), mix_w_in[layer], mix_w_out[layer], pool_w[layer],
                         pool_scale[layer], lru_conv_w[layer], lru_conv_b[layer],
                         lru_gate_w[layer], lru_gate_b[layer], lru_lambda[layer])
        x = x + rms_norm(h, g[3])
        h = swiglu(rms_norm(x, g[4]), ffn2_w_in[layer], ffn2_w_out[layer])
        x = x + 0.5 * rms_norm(h, g[5])
    return x
```

```cpp
#include <hip/hip_runtime.h>
#include <hip/hip_cooperative_groups.h>
#include <cstdio>
namespace cg = cooperative_groups;
#include <hip/hip_runtime.h>
namespace pg8 {
#define PG8_LAS __attribute__((address_space(3)))
typedef unsigned short bf16_t;
typedef short bf16x8 __attribute__((ext_vector_type(8)));
typedef float f32x4 __attribute__((ext_vector_type(4)));
typedef unsigned u32x4 __attribute__((ext_vector_type(4)));
constexpr int BM = 256, BK = 64, HALF = 128, HTB = HALF * BK * 2  , STAGE_BYTES = 8 * HTB, NXCD = 8, WGM = 8;

__host__ __device__ __forceinline__ int lds_byte(int r, int c) { const int st = (r >> 4) * 2 + (c >> 5), rr = r & 15, cc = c & 31, ob = rr * 64 + cc * 2; return st * 1024 + (ob ^ (((ob >> 9) & 1) << 5)); }
__host__ __device__ __forceinline__ void stage_rc(int b, int& R, int& C) { const int st = b / 1024, sb = b % 1024, swz = sb ^ (((sb >> 9) & 1) << 5); R = (st >> 1) * 16 + swz / 64; C = (st & 1) * 32 + (swz % 64) / 2; }
__host__ __device__ __forceinline__ int perm32(int rho) { const int n = rho >> 4, i = rho & 15; return 8 * (i >> 2) + 4 * n + (i & 3); }

struct Unit { int pm, pn; };
struct Gemm { const bf16_t* A; const bf16_t* Bt; int M, N, K; };

struct StaticOrder {
    int nM, nN, nwg, G, c;
    __host__ __device__ void init(int M, int N, int G_, int c_) { nM = M / BM; nN = N / BM; nwg = nM * nN; G = G_; c = c_; }
    __host__ __device__ bool next(int i, Unit& u) const {
        const long L = (long)i * G + c; if (L >= nwg) return false;
        int wgid = (int)L; { const int q = nwg / NXCD, r = nwg % NXCD, xcd = wgid % NXCD, off = wgid / NXCD; wgid = (xcd < r ? xcd * (q + 1) : r * (q + 1) + (xcd - r) * q) + off; }
        const int nig = WGM * nN, gid = wgid / nig, fm = gid * WGM, gsz = (nM - fm) < WGM ? (nM - fm) : WGM;
        u.pm = fm + ((wgid % nig) % gsz); u.pn = (wgid % nig) / gsz; return true;
    }
    __device__ __forceinline__ void a_ready(const Unit&) const {}
    __device__ __forceinline__ void done(const Unit&) const {}
};
__device__ __forceinline__ unsigned cvt_pk_bf16(float lo, float hi) { unsigned r; asm volatile("v_cvt_pk_bf16_f32 %0, %1, %2" : "=v"(r) : "v"(lo), "v"(hi)); return r; }
struct EpiF32 {
    static constexpr bool PERM = false, AFTER_DRAIN = false;
    float* C; int ldc; const float* bias;
    __device__ __forceinline__ void operator()(const f32x4 (&acc)[2][2][4][2], const Unit& u, int wr, int wc, int fr, int fq) const {
        const int row0 = u.pm * BM + wr * 64 + fr, col0 = u.pn * BM + wc * 32 + 4 * fq;
        f32x4 bv[2][2];
#pragma unroll
        for (int bj = 0; bj < 2; ++bj)
#pragma unroll
            for (int n = 0; n < 2; ++n) bv[bj][n] = bias ? *(const f32x4*)(bias + col0 + bj * HALF + n * 16) : (f32x4){0.f, 0.f, 0.f, 0.f};
#pragma unroll
        for (int ai = 0; ai < 2; ++ai)
#pragma unroll
            for (int m = 0; m < 4; ++m) { float* rowp = C + (size_t)(row0 + ai * HALF + m * 16) * ldc + col0;
#pragma unroll
                for (int bj = 0; bj < 2; ++bj)
#pragma unroll
                    for (int n = 0; n < 2; ++n) *(f32x4*)(rowp + bj * HALF + n * 16) = acc[ai][bj][m][n] + bv[bj][n]; }
    }
};
typedef unsigned u32x2 __attribute__((ext_vector_type(2)));
struct EpiBf16P {
    static constexpr bool PERM = true, AFTER_DRAIN = false;
    bf16_t* O; int ldc;
    __device__ __forceinline__ void operator()(const f32x4 (&acc)[2][2][4][2], const Unit& u, int wr, int wc, int fr, int fq) const {
        const int row0 = u.pm * BM + wr * 64 + fr, col0 = u.pn * BM + wc * 32 + 8 * fq;
#pragma unroll
        for (int ai = 0; ai < 2; ++ai)
#pragma unroll
            for (int m = 0; m < 4; ++m) { bf16_t* rowp = O + (size_t)(row0 + ai * HALF + m * 16) * ldc + col0;
#pragma unroll
                for (int bj = 0; bj < 2; ++bj) { const f32x4 v0 = acc[ai][bj][m][0], v1 = acc[ai][bj][m][1];
                    u32x4 w; w.x = cvt_pk_bf16(v0[0], v0[1]); w.y = cvt_pk_bf16(v0[2], v0[3]); w.z = cvt_pk_bf16(v1[0], v1[1]); w.w = cvt_pk_bf16(v1[2], v1[3]);
                    *(u32x4*)(rowp + bj * HALF) = w; } }
    }
};
__device__ __forceinline__ float silu_mul(float g, float u) { return g * u * __builtin_amdgcn_rcpf(1.0f + __expf(-g)); }
struct EpiSwiGLU {
    static constexpr bool PERM = true, AFTER_DRAIN = false;
    bf16_t* O; int ldc;
    __device__ __forceinline__ void operator()(const f32x4 (&acc)[2][2][4][2], const Unit& u, int wr, int wc, int fr, int fq) const {
        const int row0 = u.pm * BM + wr * 64 + fr, col0 = u.pn * HALF + wc * 32 + 8 * fq;
#pragma unroll
        for (int ai = 0; ai < 2; ++ai)
#pragma unroll
            for (int m = 0; m < 4; ++m) { bf16_t* rowp = O + (size_t)(row0 + ai * HALF + m * 16) * ldc + col0;
                const f32x4 g0 = acc[ai][0][m][0], g1 = acc[ai][0][m][1], u0 = acc[ai][1][m][0], u1 = acc[ai][1][m][1];
                u32x4 w; w.x = cvt_pk_bf16(silu_mul(g0[0], u0[0]), silu_mul(g0[1], u0[1])); w.y = cvt_pk_bf16(silu_mul(g0[2], u0[2]), silu_mul(g0[3], u0[3]));
                w.z = cvt_pk_bf16(silu_mul(g1[0], u1[0]), silu_mul(g1[1], u1[1])); w.w = cvt_pk_bf16(silu_mul(g1[2], u1[2]), silu_mul(g1[3], u1[3]));
                *(u32x4*)rowp = w; }
    }
};

template <class Epi, class Sched, bool ALIGN_EPI = false, bool SP2 = false>
__device__ __forceinline__ void gemm_phase(PG8_LAS unsigned char* lds, const Gemm g, const Sched& S, const Epi& E) {
    int tid_l = threadIdx.x; asm volatile("" : "+v"(tid_l));
    const int tid = tid_l, wid = __builtin_amdgcn_readfirstlane(tid >> 6), lane = tid & 63, wr = wid >> 2, wc = wid & 3, fr = lane & 15, fq = lane >> 4;
    const int K = g.K, nt = K / BK;
    unsigned voffA[2], voffB[2];
#pragma unroll
    for (int i = 0; i < 2; ++i) { int R, C; stage_rc(tid * 16 + i * 8192, R, C); const int Rb = Epi::PERM ? ((R & ~31) + perm32(R & 31)) : R;
        voffA[i] = (unsigned)(R * K + C) * 2u; voffB[i] = (unsigned)(Rb * K + C) * 2u; }
    const size_t kstep = (size_t)(BK * 2);
    const size_t hstep = (size_t)HALF * K * 2;
    const size_t tstep = 2 * hstep;
    const unsigned ldsw = (unsigned)wid * 1024u;
    const int aoff = lds_byte(wr * 64 + fr, fq * 8), boff = lds_byte(wc * 32 + fr, fq * 8);
#define PG8_SA(b, h) (((b) * 2 + (h)) * HTB)
#define PG8_SB(b, h) ((4 + (b) * 2 + (h)) * HTB)
#define PG8_STAGE(bufoff, gbase, voff) do { _Pragma("unroll") for (int _i = 0; _i < 2; ++_i) \
        __builtin_amdgcn_global_load_lds((const unsigned*)((const char*)(gbase) + (voff)[_i]), (PG8_LAS unsigned*)(lds + (bufoff) + ldsw + _i * 8192), 16, 0, 0); } while (0)
#define PG8_LDA(dst, b, h) do { _Pragma("unroll") for (int m = 0; m < 4; ++m) _Pragma("unroll") for (int k = 0; k < 2; ++k) dst[m][k] = *(const PG8_LAS bf16x8*)(lds + PG8_SA(b, h) + aoff + m * 2048 + k * 1024); } while (0)
#define PG8_LDB(dst, b, h) do { _Pragma("unroll") for (int n = 0; n < 2; ++n) _Pragma("unroll") for (int k = 0; k < 2; ++k) dst[n][k] = *(const PG8_LAS bf16x8*)(lds + PG8_SB(b, h) + boff + n * 2048 + k * 1024); } while (0)
#define PG8_MMA(ai, bj, At, Bt) do { __builtin_amdgcn_s_setprio(1); _Pragma("unroll") for (int m = 0; m < 4; ++m) _Pragma("unroll") for (int n = 0; n < 2; ++n) _Pragma("unroll") for (int k = 0; k < 2; ++k) \
        acc[ai][bj][m][n] = __builtin_amdgcn_mfma_f32_16x16x32_bf16(Bt[n][k], At[m][k], acc[ai][bj][m][n], 0, 0, 0); __builtin_amdgcn_s_setprio(0); } while (0)
#define PG8_WAIT_V(n) asm volatile("s_waitcnt vmcnt(" #n ")" ::: "memory")
#define PG8_WAIT_L(n) asm volatile("s_waitcnt lgkmcnt(" #n ")" ::: "memory")
#define PG8_BAR __builtin_amdgcn_s_barrier()
#define PG8_SCHED __builtin_amdgcn_sched_barrier(0)
    Unit cur, nxt; int ui = 0;
    if (!S.next(0, cur)) return;
    f32x4 acc[2][2][4][2];
#pragma unroll
    for (int a = 0; a < 2; ++a)
#pragma unroll
        for (int b = 0; b < 2; ++b)
#pragma unroll
            for (int m = 0; m < 4; ++m)
#pragma unroll
                for (int n = 0; n < 2; ++n) acc[a][b][m][n] = (f32x4){0.f, 0.f, 0.f, 0.f};
    bf16x8 At[4][2], B0[2][2], B1[2][2];
    const char* cA = (const char*)g.A + (size_t)cur.pm * tstep; const char* cB = (const char*)g.Bt + (size_t)cur.pn * tstep;
    S.a_ready(cur);
    if constexpr (SP2) {
        PG8_STAGE(PG8_SB(0, 0), cB, voffB); PG8_STAGE(PG8_SB(0, 1), cB + hstep, voffB); PG8_STAGE(PG8_SA(0, 0), cA, voffA); PG8_STAGE(PG8_SA(0, 1), cA + hstep, voffA);
        if (wr == 1) PG8_BAR;
        PG8_WAIT_V(2); PG8_BAR;
        PG8_STAGE(PG8_SB(1, 0), cB + kstep, voffB); PG8_STAGE(PG8_SA(1, 0), cA + kstep, voffA); PG8_STAGE(PG8_SB(1, 1), cB + hstep + kstep, voffB);
        PG8_WAIT_V(6); PG8_BAR;
    } else {
        PG8_STAGE(PG8_SB(0, 0), cB, voffB); PG8_STAGE(PG8_SA(0, 0), cA, voffA); PG8_STAGE(PG8_SB(0, 1), cB + hstep, voffB); PG8_STAGE(PG8_SA(0, 1), cA + hstep, voffA);
        if (wr == 1) PG8_BAR;
        PG8_WAIT_V(4); PG8_BAR;
        PG8_STAGE(PG8_SB(1, 0), cB + kstep, voffB); PG8_STAGE(PG8_SA(1, 0), cA + kstep, voffA); PG8_STAGE(PG8_SB(1, 1), cB + hstep + kstep, voffB);
        PG8_WAIT_V(6); PG8_BAR;
    }
    for (;;) {
        const bool has_next = S.next(ui + 1, nxt);
        const char* nA = has_next ? (const char*)g.A + (size_t)nxt.pm * tstep : cA; const char* nB = has_next ? (const char*)g.Bt + (size_t)nxt.pn * tstep : cB;
        for (int t = 0; t < nt; t += 2) {
            const bool last = (t == nt - 2);
            const char* a1 = cA + (size_t)(t + 1) * kstep;
            const char* a2 = last ? nA : cA + (size_t)(t + 2) * kstep; const char* b2 = last ? nB : cB + (size_t)(t + 2) * kstep;
            const char* a3 = a2 + kstep; const char* b3 = b2 + kstep;
            if (last && has_next) S.a_ready(nxt);
            if constexpr (SP2) {
            PG8_LDB(B0, 0, 0); PG8_LDB(B1, 0, 1); PG8_SCHED; PG8_LDA(At, 0, 0); PG8_STAGE(PG8_SA(1, 1), a1 + hstep, voffA);
            PG8_WAIT_V(8); PG8_WAIT_L(0); PG8_BAR; PG8_MMA(0, 0, At, B0); PG8_MMA(0, 1, At, B1); PG8_BAR; PG8_SCHED;
            PG8_LDA(At, 0, 1); PG8_STAGE(PG8_SB(0, 0), b2, voffB); PG8_STAGE(PG8_SB(0, 1), b2 + hstep, voffB); PG8_STAGE(PG8_SA(0, 0), a2, voffA);
            PG8_WAIT_V(8); PG8_WAIT_L(0); PG8_BAR; PG8_MMA(1, 0, At, B0); PG8_MMA(1, 1, At, B1); PG8_BAR; PG8_SCHED;
            PG8_LDB(B0, 1, 0); PG8_LDB(B1, 1, 1); PG8_SCHED; PG8_LDA(At, 1, 0); PG8_STAGE(PG8_SA(0, 1), a2 + hstep, voffA);
            PG8_WAIT_V(8); PG8_WAIT_L(0); PG8_BAR; PG8_MMA(0, 0, At, B0); PG8_MMA(0, 1, At, B1); PG8_BAR; PG8_SCHED;
            PG8_LDA(At, 1, 1); PG8_STAGE(PG8_SB(1, 0), b3, voffB); PG8_STAGE(PG8_SB(1, 1), b3 + hstep, voffB); PG8_STAGE(PG8_SA(1, 0), a3, voffA);
            PG8_WAIT_V(8); PG8_WAIT_L(0); PG8_BAR; PG8_MMA(1, 0, At, B0); PG8_MMA(1, 1, At, B1); PG8_BAR; PG8_SCHED;
            } else {
            PG8_LDB(B0, 0, 0); PG8_SCHED; PG8_LDA(At, 0, 0); PG8_STAGE(PG8_SA(1, 1), a1 + hstep, voffA);
            PG8_WAIT_L(8); PG8_BAR; PG8_WAIT_L(0); PG8_MMA(0, 0, At, B0); PG8_BAR; PG8_SCHED;
            PG8_LDB(B1, 0, 1); PG8_STAGE(PG8_SB(0, 0), b2, voffB);
            PG8_BAR; PG8_WAIT_L(0); PG8_MMA(0, 1, At, B1); PG8_BAR;
            PG8_LDA(At, 0, 1); PG8_STAGE(PG8_SA(0, 0), a2, voffA);
            PG8_BAR; PG8_WAIT_L(0); PG8_MMA(1, 0, At, B0); PG8_BAR; PG8_SCHED;
            PG8_STAGE(PG8_SB(0, 1), b2 + hstep, voffB);
            PG8_WAIT_V(6); PG8_BAR; PG8_MMA(1, 1, At, B1); PG8_BAR;
            PG8_LDB(B0, 1, 0); PG8_SCHED; PG8_LDA(At, 1, 0); PG8_STAGE(PG8_SA(0, 1), a2 + hstep, voffA);
            PG8_WAIT_L(8); PG8_BAR; PG8_WAIT_L(0); PG8_MMA(0, 0, At, B0); PG8_BAR; PG8_SCHED;
            PG8_LDB(B1, 1, 1); PG8_STAGE(PG8_SB(1, 0), b3, voffB);
            PG8_BAR; PG8_WAIT_L(0); PG8_MMA(0, 1, At, B1); PG8_BAR;
            PG8_LDA(At, 1, 1); PG8_STAGE(PG8_SA(1, 0), a3, voffA);
            PG8_BAR; PG8_WAIT_L(0); PG8_MMA(1, 0, At, B0); PG8_BAR; PG8_SCHED;
            PG8_STAGE(PG8_SB(1, 1), b3 + hstep, voffB);
            PG8_WAIT_V(6); PG8_BAR; PG8_MMA(1, 1, At, B1); PG8_BAR;
            }
        }
        if constexpr (ALIGN_EPI) { if (wr == 0) PG8_BAR; }
        if constexpr (!Epi::AFTER_DRAIN) { E(acc, cur, wr, wc, fr, fq); S.done(cur); }
        if (!has_next) break;
#pragma unroll
        for (int a = 0; a < 2; ++a)
#pragma unroll
            for (int b = 0; b < 2; ++b)
#pragma unroll
                for (int m = 0; m < 4; ++m)
#pragma unroll
                    for (int n = 0; n < 2; ++n) acc[a][b][m][n] = (f32x4){0.f, 0.f, 0.f, 0.f};
        cur = nxt; cA = nA; cB = nB; ++ui;
        if constexpr (ALIGN_EPI) { if (wr == 1) PG8_BAR; }
    }
    PG8_WAIT_V(0);
    if constexpr (!ALIGN_EPI) { if (wr == 0) PG8_BAR; }
    PG8_BAR;
    if constexpr (Epi::AFTER_DRAIN) { E.fused(acc, cur, wr, wc, fr, fq, lds, wid, lane); S.done(cur); }
#undef PG8_SA
#undef PG8_SB
#undef PG8_STAGE
#undef PG8_LDA
#undef PG8_LDB
#undef PG8_MMA
#undef PG8_WAIT_V
#undef PG8_WAIT_L
#undef PG8_BAR
#undef PG8_SCHED
}
}

using pg8::bf16_t; using pg8::bf16x8; using pg8::f32x4; using pg8::u32x4; using pg8::u32x2; using pg8::cvt_pk_bf16;
#define LAS __attribute__((address_space(3)))

constexpr int S_ = 16384, D_ = 2048, DFF_ = 5632, INW_ = 4608, DEPTH_ = 2;
constexpr int LDS_BYTES = 131072;
constexpr size_t SZ_WIN = (size_t)2 * DFF_ * D_ * 2, SZ_WOUT = (size_t)D_ * DFF_ * 2, SZ_WMIN = (size_t)INW_ * D_ * 2, SZ_WMOUT = (size_t)D_ * D_ * 2;
constexpr size_t OFF_W1IN = 0, OFF_W1OUT = OFF_W1IN + SZ_WIN, OFF_WMIN = OFF_W1OUT + SZ_WOUT, OFF_WMOUT = OFF_WMIN + SZ_WMIN, OFF_W2IN = OFF_WMOUT + SZ_WMOUT, OFF_W2OUT = OFF_W2IN + SZ_WIN;
constexpr size_t OFF_POOLW = OFF_W2OUT + SZ_WOUT, OFF_GATEW = OFF_POOLW + 131072, OFF_LSUM = OFF_GATEW + 131072;
constexpr size_t OFF_XN = OFF_LSUM + 524288, OFF_HID = OFF_XN + (size_t)S_ * D_ * 2, OFF_H = OFF_HID + (size_t)S_ * DFF_ * 2, OFF_Y = OFF_H + (size_t)S_ * D_ * 4, WS_END = OFF_Y + (size_t)S_ * D_ * 2;
constexpr int NPHASE = 1 + 11 * DEPTH_;

struct Params { const float* in[15]; float* out; unsigned char* ws; };

__device__ __forceinline__ int ltid() { int t = threadIdx.x; asm volatile("" : "+v"(t)); return t; }
__device__ __forceinline__ float bf2f(unsigned short b) { return __uint_as_float(((unsigned)b) << 16); }
__device__ __forceinline__ float wave_sum(float v) {
#pragma unroll
    for (int o = 32; o > 0; o >>= 1) v += __shfl_xor(v, o);
    return v;
}

__device__ __forceinline__ void convert_tile(LAS unsigned char* lds, const float* __restrict__ src, bf16_t* __restrict__ dst, int K, int srcN, int perm, int nt_idx, int kt_idx, int tid) {
    const int n = tid & 63, kg = tid >> 6;
    const int np0 = nt_idx * 64;
    int sc0 = np0;
    if (perm) { const int pn = np0 >> 8, bj = (np0 >> 7) & 1, j = np0 & 127; sc0 = bj * DFF_ + pn * 128 + j; }
    const float* s = src + (size_t)(kt_idx * 128 + kg * 16) * srcN + sc0 + n;
    float v[16];
#pragma unroll
    for (int i = 0; i < 16; ++i) v[i] = __builtin_nontemporal_load(s + (size_t)i * srcN);
#pragma unroll
    for (int i = 0; i < 4; ++i) { u32x2 w; w.x = cvt_pk_bf16(v[i * 4], v[i * 4 + 1]); w.y = cvt_pk_bf16(v[i * 4 + 2], v[i * 4 + 3]);
        *(LAS u32x2*)(lds + n * 264 + (kg * 4 + i) * 8) = w; }
    __syncthreads();
#pragma unroll
    for (int pass = 0; pass < 2; ++pass) { const int row = pass * 32 + (tid >> 4), c = tid & 15;
        const u32x2 a = *(const LAS u32x2*)(lds + row * 264 + c * 16), b = *(const LAS u32x2*)(lds + row * 264 + c * 16 + 8);
        u32x4 o; o.x = a.x; o.y = a.y; o.z = b.x; o.w = b.y;
        *(u32x4*)(dst + (size_t)(np0 + row) * K + kt_idx * 128 + c * 8) = o; }
    __syncthreads();
}

__device__ __forceinline__ void convert_phase(LAS unsigned char* lds, const Params& p, int layer) {
    unsigned char* ws = p.ws; const int tid = ltid();
    const int ntiles[6] = {2816, 1408, 1152, 512, 2816, 1408};
    int total = 0;
#pragma unroll
    for (int j = 0; j < 6; ++j) total += ntiles[j];
    for (int T = blockIdx.x; T < total; T += gridDim.x) {
        int loc = T; int job = 0;
#pragma unroll
        for (int j = 0; j < 5; ++j) if (job == j && loc >= ntiles[j]) { loc -= ntiles[j]; job = j + 1; }
        const float* src; bf16_t* dst; int K, srcN, perm, ntn;
        switch (job) {
            case 0: src = p.in[2] + (size_t)layer * D_ * 2 * DFF_; dst = (bf16_t*)(ws + OFF_W1IN); K = D_; srcN = 2 * DFF_; perm = 1; ntn = 2 * DFF_ / 64; break;
            case 1: src = p.in[3] + (size_t)layer * DFF_ * D_; dst = (bf16_t*)(ws + OFF_W1OUT); K = DFF_; srcN = D_; perm = 0; ntn = D_ / 64; break;
            case 2: src = p.in[4] + (size_t)layer * D_ * INW_; dst = (bf16_t*)(ws + OFF_WMIN); K = D_; srcN = INW_; perm = 0; ntn = INW_ / 64; break;
            case 3: src = p.in[5] + (size_t)layer * D_ * D_; dst = (bf16_t*)(ws + OFF_WMOUT); K = D_; srcN = D_; perm = 0; ntn = D_ / 64; break;
            case 4: src = p.in[13] + (size_t)layer * D_ * 2 * DFF_; dst = (bf16_t*)(ws + OFF_W2IN); K = D_; srcN = 2 * DFF_; perm = 1; ntn = 2 * DFF_ / 64; break;
            default: src = p.in[14] + (size_t)layer * DFF_ * D_; dst = (bf16_t*)(ws + OFF_W2OUT); K = DFF_; srcN = D_; perm = 0; ntn = D_ / 64; break;
        }
        const int kt = loc / ntn, nt = loc - kt * ntn;
        convert_tile(lds, src, dst, K, srcN, perm, nt, kt, tid);
    }
    const float* pw = p.in[6] + (size_t)layer * 65536; const float* gw = p.in[10] + (size_t)layer * 65536;
    bf16_t* pwt = (bf16_t*)(ws + OFF_POOLW); bf16_t* gwt = (bf16_t*)(ws + OFF_GATEW);
    for (int i = blockIdx.x * 512 + tid; i < 131072; i += gridDim.x * 512) {
        if (i < 65536) { const int g = i >> 14, d = (i >> 7) & 127, c = i & 127; pwt[i] = (bf16_t)(cvt_pk_bf16(pw[(g * 128 + c) * 128 + d], 0.f) & 0xffffu); }
        else { const int k = i - 65536; const int gh = k >> 12, d = (k >> 6) & 63, c = k & 63; gwt[k] = (bf16_t)(cvt_pk_bf16(gw[(gh * 64 + c) * 64 + d], 0.f) & 0xffffu); }
    }
}

__device__ __forceinline__ void norm_phase(const float* __restrict__ h, const float* xs, float* xd, float coef, const float* __restrict__ ga, const float* __restrict__ gb, bf16_t* __restrict__ xn) {
    const int tid = ltid(); const int lane = tid & 63, gwv = blockIdx.x * 8 + (tid >> 6), GW = gridDim.x * 8;
    for (int row = gwv; row < S_; row += GW) {
        f32x4 xv[8];
        const f32x4* xr = (const f32x4*)(xs + (size_t)row * D_);
#pragma unroll
        for (int i = 0; i < 8; ++i) xv[i] = xr[lane + i * 64];
        if (h) {
            f32x4 hv[8]; const f32x4* hr = (const f32x4*)(h + (size_t)row * D_); float ss = 0.f;
#pragma unroll
            for (int i = 0; i < 8; ++i) { hv[i] = hr[lane + i * 64]; ss += hv[i][0] * hv[i][0] + hv[i][1] * hv[i][1] + hv[i][2] * hv[i][2] + hv[i][3] * hv[i][3]; }
            ss = wave_sum(ss);
            const float rs = coef * rsqrtf(ss * (1.0f / D_) + 1e-6f);
            f32x4* xw = (f32x4*)(xd + (size_t)row * D_);
#pragma unroll
            for (int i = 0; i < 8; ++i) { const f32x4 g = ((const f32x4*)ga)[lane + i * 64]; xv[i] = xv[i] + hv[i] * g * rs; xw[lane + i * 64] = xv[i]; }
        }
        if (xn) {
            float ss = 0.f;
#pragma unroll
            for (int i = 0; i < 8; ++i) ss += xv[i][0] * xv[i][0] + xv[i][1] * xv[i][1] + xv[i][2] * xv[i][2] + xv[i][3] * xv[i][3];
            ss = wave_sum(ss);
            const float rs = rsqrtf(ss * (1.0f / D_) + 1e-6f);
            u32x2* xo = (u32x2*)(xn + (size_t)row * D_);
#pragma unroll
            for (int i = 0; i < 8; ++i) { const f32x4 g = ((const f32x4*)gb)[lane + i * 64]; const f32x4 y = xv[i] * g * rs; u32x2 w; w.x = cvt_pk_bf16(y[0], y[1]); w.y = cvt_pk_bf16(y[2], y[3]); xo[lane + i * 64] = w; }
        }
    }
}

#define MFMA16(a, b, c) __builtin_amdgcn_mfma_f32_16x16x32_bf16((a), (b), (c), 0, 0, 0)

__device__ __forceinline__ void attn_item(const bf16_t* __restrict__ z, bf16_t* __restrict__ y, int item, int lane) {
    const int fr = lane & 15, fq = lane >> 4;
    const int Bblk = item >> 8, head = (item >> 4) & 15, r = item & 15;
    const int P0 = Bblk * 256 + r, pq = P0 + 16 * fr;
    const float slope = exp2f(-0.5f * (float)(head + 1));
    const bf16_t* zq = z + (size_t)pq * INW_ + 1536 + head * 64 + fq * 8;
    const bf16x8 qf0 = *(const bf16x8*)zq, qf1 = *(const bf16x8*)(zq + 32);
    const bf16_t* zk = z + 2560 + head * 64 + fq * 8;
    const bf16_t* zv = z + 3584 + head * 64 + fr;
    float m = -1e30f, l = 0.f;
    f32x4 o[4];
#pragma unroll
    for (int i = 0; i < 4; ++i) o[i] = (f32x4){0.f, 0.f, 0.f, 0.f};
    for (int br = 0; br < 3; ++br) {
        const int sh = 2 * br, start = P0 - (128 << sh), nch = (br == 0) ? 12 : (br == 1 ? 6 : 5), wmax = 128 << sh;
        for (int c = 0; c < nch; ++c) {
            const int kb = start + ((c * 32) << sh);
            f32x4 st[2];
#pragma unroll
            for (int t = 0; t < 2; ++t) {
                int kp = kb + ((t * 16 + fr) << sh); kp = kp < 0 ? 0 : (kp > S_ - 1 ? S_ - 1 : kp);
                const bf16_t* kr = zk + (size_t)kp * INW_;
                const bf16x8 k0 = *(const bf16x8*)kr, k1 = *(const bf16x8*)(kr + 32);
                st[t] = MFMA16(k0, qf0, ((f32x4){0.f, 0.f, 0.f, 0.f}));
                st[t] = MFMA16(k1, qf1, st[t]);
            }
            bf16x8 vf[4];
#pragma unroll
            for (int i = 0; i < 8; ++i) {
                int kp = kb + (((i >> 2) * 16 + fq * 4 + (i & 3)) << sh); kp = kp < 0 ? 0 : (kp > S_ - 1 ? S_ - 1 : kp);
                const bf16_t* vr = zv + (size_t)kp * INW_;
#pragma unroll
                for (int dvt = 0; dvt < 4; ++dvt) vf[dvt][i] = (short)vr[dvt * 16];
            }
            float sv[8]; bool ok[8]; float cmax = -1e30f;
#pragma unroll
            for (int i = 0; i < 8; ++i) {
                const int kp = kb + (((i >> 2) * 16 + fq * 4 + (i & 3)) << sh), delta = pq - kp;
                ok[i] = (delta >= 0) && (delta <= wmax) && (kp >= 0);
                sv[i] = ok[i] ? st[i >> 2][i & 3] * 0.125f - slope * (float)delta : -1e30f;
                cmax = fmaxf(cmax, sv[i]);
            }
            cmax = fmaxf(cmax, __shfl_xor(cmax, 16)); cmax = fmaxf(cmax, __shfl_xor(cmax, 32));
            const float mn = fmaxf(m, cmax), alpha = __expf(m - mn);
            m = mn;
            float ps = 0.f; float pv[8];
#pragma unroll
            for (int i = 0; i < 8; ++i) { pv[i] = ok[i] ? __expf(sv[i] - mn) : 0.f; ps += pv[i]; }
            l = l * alpha + ps;
            bf16x8 pf; u32x4 pw; pw.x = cvt_pk_bf16(pv[0], pv[1]); pw.y = cvt_pk_bf16(pv[2], pv[3]); pw.z = cvt_pk_bf16(pv[4], pv[5]); pw.w = cvt_pk_bf16(pv[6], pv[7]);
            pf = __builtin_bit_cast(bf16x8, pw);
#pragma unroll
            for (int dvt = 0; dvt < 4; ++dvt) { o[dvt] = o[dvt] * alpha; o[dvt] = MFMA16(vf[dvt], pf, o[dvt]); }
        }
    }
    l += __shfl_xor(l, 16); l += __shfl_xor(l, 32);
    const float inv = 1.0f / l;
    bf16_t* yo = y + (size_t)pq * D_ + 1024 + head * 64 + fq * 4;
#pragma unroll
    for (int dvt = 0; dvt < 4; ++dvt) { u32x2 w; w.x = cvt_pk_bf16(o[dvt][0] * inv, o[dvt][1] * inv); w.y = cvt_pk_bf16(o[dvt][2] * inv, o[dvt][3] * inv); *(u32x2*)(yo + dvt * 16) = w; }
}

__device__ __forceinline__ void pool_item(const bf16_t* __restrict__ z, bf16_t* __restrict__ y, const bf16_t* __restrict__ pwt, const float* __restrict__ scale, int item, int lane) {
    const int fr = lane & 15, fq = lane >> 4;
    const int gi = item & 3, tt = item >> 2, t = tt * 16 + fr, win = 2 << gi;
    const float invn = 1.0f / (float)((t + 1) < win ? (t + 1) : win);
    bf16x8 pf[4];
#pragma unroll
    for (int kk = 0; kk < 4; ++kk) {
        const bf16_t* zc = z + gi * 128 + kk * 32 + fq * 8;
        float s[8];
#pragma unroll
        for (int e = 0; e < 8; ++e) s[e] = 0.f;
        const bf16x8 self = *(const bf16x8*)(zc + (size_t)t * INW_);
        for (int j = 0; j < win; ++j) { const int tj = t - j; if (tj >= 0) { const bf16x8 v = *(const bf16x8*)(zc + (size_t)tj * INW_);
#pragma unroll
                for (int e = 0; e < 8; ++e) s[e] += bf2f((unsigned short)v[e]); } }
        u32x4 w;
        w.x = cvt_pk_bf16(s[0] * invn - bf2f((unsigned short)self[0]), s[1] * invn - bf2f((unsigned short)self[1]));
        w.y = cvt_pk_bf16(s[2] * invn - bf2f((unsigned short)self[2]), s[3] * invn - bf2f((unsigned short)self[3]));
        w.z = cvt_pk_bf16(s[4] * invn - bf2f((unsigned short)self[4]), s[5] * invn - bf2f((unsigned short)self[5]));
        w.w = cvt_pk_bf16(s[6] * invn - bf2f((unsigned short)self[6]), s[7] * invn - bf2f((unsigned short)self[7]));
        pf[kk] = __builtin_bit_cast(bf16x8, w);
    }
    const bf16_t* wb = pwt + (size_t)gi * 16384 + fr * 128 + fq * 8;
    bf16_t* yo = y + (size_t)t * D_ + gi * 128 + fq * 4;
    const float* sc = scale + gi * 128 + fq * 4;
#pragma unroll
    for (int dt = 0; dt < 8; ++dt) {
        f32x4 acc = (f32x4){0.f, 0.f, 0.f, 0.f};
#pragma unroll
        for (int kk = 0; kk < 4; ++kk) { const bf16x8 wf = *(const bf16x8*)(wb + dt * 16 * 128 + kk * 32); acc = MFMA16(wf, pf[kk], acc); }
        const f32x4 s4 = *(const f32x4*)(sc + dt * 16);
        u32x2 w; w.x = cvt_pk_bf16(acc[0] * s4[0], acc[1] * s4[1]); w.y = cvt_pk_bf16(acc[2] * s4[2], acc[3] * s4[3]);
        *(u32x2*)(yo + dt * 16) = w;
    }
}

__device__ __forceinline__ void lru_item(LAS unsigned char* wlds, const bf16_t* __restrict__ z, const Params& p, int layer, const bf16_t* __restrict__ gwt,
                                         float* __restrict__ HL, float* __restrict__ PC, float* __restrict__ sumP, float* __restrict__ sumH, int item, int lane) {
    const int fr = lane & 15, fq = lane >> 4;
    const int hh = item & 7, ck = item >> 3, T0 = ck * 128;
    const float* convw = p.in[8] + (size_t)layer * 4 * 512 + hh * 64;
    const float* convb = p.in[9] + (size_t)layer * 512 + hh * 64;
    const float* gb = p.in[11] + (size_t)layer * 1024;
    const float* lam = p.in[12] + (size_t)layer * 512 + hh * 64;
    LAS float* Al = (LAS float*)wlds; LAS float* Gl = (LAS float*)(wlds + 4224);
    float br_[4], bi_[4], sp_[4];
#pragma unroll
    for (int nt = 0; nt < 4; ++nt) { const int d = nt * 16 + fr; br_[nt] = gb[hh * 64 + d]; bi_[nt] = gb[512 + hh * 64 + d];
        const float nl = -lam[d]; sp_[nt] = (nl > 20.f) ? nl : log1pf(__expf(nl)); }
    const float w0 = convw[lane], w1 = convw[512 + lane], w2 = convw[1024 + lane], w3 = convw[1536 + lane], cb = convb[lane];
    const bf16_t* zx = z + 512 + hh * 64;
    float xm3 = (T0 >= 3) ? bf2f(zx[(size_t)(T0 - 3) * INW_ + lane]) : 0.f, xm2 = (T0 >= 2) ? bf2f(zx[(size_t)(T0 - 2) * INW_ + lane]) : 0.f, xm1 = (T0 >= 1) ? bf2f(zx[(size_t)(T0 - 1) * INW_ + lane]) : 0.f;
    float hst = 0.f, pst = 1.f;
    for (int sub = 0; sub < 8; ++sub) {
        const int t0 = T0 + sub * 16, t = t0 + fr;
        bf16x8 xf[2];
#pragma unroll
        for (int kk = 0; kk < 2; ++kk) {
            const int c0 = kk * 32 + fq * 8;
            float a[8];
            { const f32x4 b0 = *(const f32x4*)(convb + c0), b1 = *(const f32x4*)(convb + c0 + 4); a[0] = b0[0]; a[1] = b0[1]; a[2] = b0[2]; a[3] = b0[3]; a[4] = b1[0]; a[5] = b1[1]; a[6] = b1[2]; a[7] = b1[3]; }
#pragma unroll
            for (int tap = 0; tap < 4; ++tap) { const int tj = t - 3 + tap;
                const f32x4 wa = *(const f32x4*)(convw + tap * 512 + c0), wb = *(const f32x4*)(convw + tap * 512 + c0 + 4);
                bf16x8 v = (bf16x8){0, 0, 0, 0, 0, 0, 0, 0};
                if (tj >= 0) v = *(const bf16x8*)(zx + (size_t)tj * INW_ + c0);
                a[0] += wa[0] * bf2f((unsigned short)v[0]); a[1] += wa[1] * bf2f((unsigned short)v[1]); a[2] += wa[2] * bf2f((unsigned short)v[2]); a[3] += wa[3] * bf2f((unsigned short)v[3]);
                a[4] += wb[0] * bf2f((unsigned short)v[4]); a[5] += wb[1] * bf2f((unsigned short)v[5]); a[6] += wb[2] * bf2f((unsigned short)v[6]); a[7] += wb[3] * bf2f((unsigned short)v[7]); }
            u32x4 w; w.x = cvt_pk_bf16(a[0], a[1]); w.y = cvt_pk_bf16(a[2], a[3]); w.z = cvt_pk_bf16(a[4], a[5]); w.w = cvt_pk_bf16(a[6], a[7]);
            xf[kk] = __builtin_bit_cast(bf16x8, w);
        }
#pragma unroll
        for (int nt = 0; nt < 4; ++nt) {
            f32x4 ar = (f32x4){0.f, 0.f, 0.f, 0.f}, ai = (f32x4){0.f, 0.f, 0.f, 0.f};
#pragma unroll
            for (int kk = 0; kk < 2; ++kk) {
                const bf16x8 wr = *(const bf16x8*)(gwt + (size_t)(hh * 64 + nt * 16 + fr) * 64 + kk * 32 + fq * 8);
                const bf16x8 wi = *(const bf16x8*)(gwt + (size_t)((8 + hh) * 64 + nt * 16 + fr) * 64 + kk * 32 + fq * 8);
                ar = MFMA16(xf[kk], wr, ar); ai = MFMA16(xf[kk], wi, ai);
            }
#pragma unroll
            for (int j = 0; j < 4; ++j) {
                const float rg = __builtin_amdgcn_rcpf(1.0f + __expf(-(ar[j] + br_[nt]))), ig = __builtin_amdgcn_rcpf(1.0f + __expf(-(ai[j] + bi_[nt])));
                const float la = -8.0f * rg * sp_[nt];
                const float av = __expf(la), gu = sqrtf(-expm1f(2.0f * la)) * ig;
                Al[(fq * 4 + j) * 66 + nt * 16 + fr] = av; Gl[(fq * 4 + j) * 66 + nt * 16 + fr] = gu;
            }
        }
        asm volatile("s_waitcnt lgkmcnt(0)" ::: "memory");
        float xz[16];
#pragma unroll
        for (int tt = 0; tt < 16; ++tt) xz[tt] = bf2f(zx[(size_t)(t0 + tt) * INW_ + lane]);
#pragma unroll
        for (int tt = 0; tt < 16; ++tt) {
            const float xc = cb + w0 * xm3 + w1 * xm2 + w2 * xm1 + w3 * xz[tt];
            xm3 = xm2; xm2 = xm1; xm1 = xz[tt];
            const float av = Al[tt * 66 + lane], gu = Gl[tt * 66 + lane];
            hst = av * hst + gu * xc; pst = pst * av;
            HL[(size_t)(t0 + tt) * 512 + hh * 64 + lane] = hst; PC[(size_t)(t0 + tt) * 512 + hh * 64 + lane] = pst;
        }
        asm volatile("s_waitcnt lgkmcnt(0)" ::: "memory");
    }
    sumP[ck * 512 + hh * 64 + lane] = pst; sumH[ck * 512 + hh * 64 + lane] = hst;
}

__device__ __forceinline__ void mixers_phase(LAS unsigned char* lds, const Params& p, int layer) {
    const bf16_t* z = (const bf16_t*)(p.ws + OFF_HID); bf16_t* y = (bf16_t*)(p.ws + OFF_Y);
    float* HL = (float*)(p.ws + OFF_XN); float* PC = HL + (size_t)S_ * 512;
    float* sumP = (float*)(p.ws + OFF_LSUM); float* sumH = sumP + 128 * 512;
    const int tid = ltid(); const int lane = tid & 63;
    const int wid = __builtin_amdgcn_readfirstlane(tid >> 6);
    const int gwv = blockIdx.x * 8 + wid, GW = gridDim.x * 8;
    constexpr int N_LRU = 1024, N_ATT = 16384, N_POOL = 4096;
    for (int i = gwv; i < N_LRU + N_ATT + N_POOL; i += GW) {
        if (i < N_LRU) lru_item(lds + wid * 8448, z, p, layer, (const bf16_t*)(p.ws + OFF_GATEW), HL, PC, sumP, sumH, i, lane);
        else if (i < N_LRU + N_ATT) attn_item(z, y, i - N_LRU, lane);
        else pool_item(z, y, (const bf16_t*)(p.ws + OFF_POOLW), p.in[7] + (size_t)layer * 512, i - N_LRU - N_ATT, lane);
    }
}

__device__ __forceinline__ void lru_final_phase(const Params& p) {
    const bf16_t* z = (const bf16_t*)(p.ws + OFF_HID); bf16_t* y = (bf16_t*)(p.ws + OFF_Y);
    const float* HL = (const float*)(p.ws + OFF_XN); const float* PC = HL + (size_t)S_ * 512;
    const float* sumP = (const float*)(p.ws + OFF_LSUM); const float* sumH = sumP + 128 * 512;
    const int d = ltid();
    for (int it = blockIdx.x; it < 256; it += gridDim.x) {
        const int ck = it >> 1, t0 = it * 64;
        float carry = 0.f;
#pragma unroll 8
        for (int c = 0; c < ck; ++c) carry = sumP[c * 512 + d] * carry + sumH[c * 512 + d];
#pragma unroll 8
        for (int tt = 0; tt < 64; ++tt) { const size_t t = (size_t)(t0 + tt);
            const float hv = HL[t * 512 + d] + PC[t * 512 + d] * carry;
            const float g = bf2f(z[t * INW_ + 1024 + d]);
            const float u = 0.7978845608f * (g + 0.044715f * g * g * g);
            const float th = 1.0f - 2.0f * __builtin_amdgcn_rcpf(1.0f + __expf(2.0f * u));
            const float ge = 0.5f * g * (1.0f + th);
            y[t * D_ + 512 + d] = (bf16_t)(cvt_pk_bf16(hv * ge, 0.f) & 0xffffu); }
    }
}

__global__ void __launch_bounds__(512, 2) mk_fwd(Params p, int ph_lo, int ph_hi) {
    extern __shared__ __attribute__((aligned(16))) unsigned char shm[];
    LAS unsigned char* lds = (LAS unsigned char*)shm;
    cg::grid_group grid = cg::this_grid();
    unsigned char* ws = p.ws;
    bf16_t* XN = (bf16_t*)(ws + OFF_XN); bf16_t* HID = (bf16_t*)(ws + OFF_HID); float* H = (float*)(ws + OFF_H); bf16_t* Y = (bf16_t*)(ws + OFF_Y);
    for (int ph = ph_lo; ph < ph_hi; ++ph) {
        if (ph == 0) {
            convert_phase(lds, p, 0);
            norm_phase(nullptr, p.in[0], nullptr, 0.f, nullptr, p.in[1], XN);
        } else {
            const int layer = (ph - 1) / 11, st = (ph - 1) % 11;
            const float* g = p.in[1] + (size_t)layer * 6 * D_;
            if (st == 0 || st == 8) {
                pg8::Gemm gm; gm.A = XN; gm.Bt = (const bf16_t*)(ws + (st == 0 ? OFF_W1IN : OFF_W2IN)); gm.M = S_; gm.N = 2 * DFF_; gm.K = D_;
                pg8::StaticOrder so; so.init(gm.M, gm.N, (int)gridDim.x, (int)blockIdx.x);
                pg8::EpiSwiGLU e; e.O = HID; e.ldc = DFF_;
                #ifndef NO_G1
                pg8::gemm_phase<pg8::EpiSwiGLU, pg8::StaticOrder, true, true>(lds, gm, so, e);
#endif
            } else if (st == 1 || st == 9 || st == 6) {
                pg8::Gemm gm; gm.M = S_; gm.N = D_;
                if (st == 6) { gm.A = Y; gm.Bt = (const bf16_t*)(ws + OFF_WMOUT); gm.K = D_; } else { gm.A = HID; gm.Bt = (const bf16_t*)(ws + (st == 1 ? OFF_W1OUT : OFF_W2OUT)); gm.K = DFF_; }
                pg8::StaticOrder so; so.init(gm.M, gm.N, (int)gridDim.x, (int)blockIdx.x);
                pg8::EpiF32 e; e.C = H; e.ldc = D_; e.bias = nullptr;
                #ifndef NO_G2
                pg8::gemm_phase<pg8::EpiF32, pg8::StaticOrder, true, true>(lds, gm, so, e);
#endif
            } else if (st == 3) {
                pg8::Gemm gm; gm.A = XN; gm.Bt = (const bf16_t*)(ws + OFF_WMIN); gm.M = S_; gm.N = INW_; gm.K = D_;
                pg8::StaticOrder so; so.init(gm.M, gm.N, (int)gridDim.x, (int)blockIdx.x);
                pg8::EpiBf16P e; e.O = HID; e.ldc = INW_;
                #ifndef NO_G3
                pg8::gemm_phase<pg8::EpiBf16P, pg8::StaticOrder, true, true>(lds, gm, so, e);
#endif
            } else if (st == 2) {
                norm_phase(H, layer == 0 ? p.in[0] : p.out, p.out, 0.5f, g + 1 * D_, g + 2 * D_, XN);
            } else if (st == 7) {
                norm_phase(H, p.out, p.out, 1.0f, g + 3 * D_, g + 4 * D_, XN);
            } else if (st == 10) {
                const bool more = (layer + 1 < DEPTH_);
                norm_phase(H, p.out, p.out, 0.5f, g + 5 * D_, more ? g + 6 * D_ : nullptr, more ? XN : nullptr);
                if (more) convert_phase(lds, p, layer + 1);
            } else if (st == 4) {
#ifndef NO_MIX
                mixers_phase(lds, p, layer);
#endif
            } else {
                lru_final_phase(p);
            }
        }
        if (ph + 1 < ph_hi) grid.sync();
    }
}

#ifndef MK_COOP
#define MK_COOP 1
#endif
extern "C" void kernel_launch(void* const* d_in, const int* in_sizes, int n_in, void* d_out, int out_size, void* d_ws, size_t ws_size, hipStream_t stream) {
    static int grid_blocks = 0;
    if (!grid_blocks) {
        if (n_in != 15 || out_size != S_ * D_ || ws_size < WS_END) { fprintf(stderr, "kernel_launch: unexpected shapes (n_in %d out %d ws %zu need %zu)\n", n_in, out_size, ws_size, (size_t)WS_END); grid_blocks = -1; return; }
        int dev = 0, cus = 0, per_cu = 0;
        hipGetDevice(&dev);
        hipDeviceGetAttribute(&cus, hipDeviceAttributeMultiprocessorCount, dev);
        if (hipFuncSetAttribute((const void*)mk_fwd, hipFuncAttributeMaxDynamicSharedMemorySize, LDS_BYTES) != hipSuccess) { fprintf(stderr, "kernel_launch: hipFuncSetAttribute failed\n"); grid_blocks = -1; return; }
        hipOccupancyMaxActiveBlocksPerMultiprocessor(&per_cu, (const void*)mk_fwd, 512, LDS_BYTES);
        if (per_cu < 1) { fprintf(stderr, "kernel_launch: occupancy query says %d\n", per_cu); per_cu = 1; }
        (void)hipGetLastError();
        grid_blocks = cus * per_cu;
    }
    if (grid_blocks < 0) return;
    Params p{};
    for (int i = 0; i < 15; ++i) p.in[i] = (const float*)d_in[i];
    p.out = (float*)d_out; p.ws = (unsigned char*)d_ws;
#if MK_COOP
    int lo = 0, hi = NPHASE;
    void* args[] = {&p, &lo, &hi};
    hipError_t e = hipLaunchCooperativeKernel((const void*)mk_fwd, dim3(grid_blocks), dim3(512), args, LDS_BYTES, stream);
    if (e != hipSuccess) fprintf(stderr, "cooperative launch failed: %s (grid %d)\n", hipGetErrorString(e), grid_blocks);
#else
    for (int ph = 0; ph < NPHASE; ++ph) hipLaunchKernelGGL(mk_fwd, dim3(grid_blocks), dim3(512), LDS_BYTES, stream, p, ph, ph + 1);
#endif
}
```

```cpp
#include <hip/hip_runtime.h>
#include <hip/hip_cooperative_groups.h>
#include <cstdio>
namespace cg = cooperative_groups;
#define XB_TMO      128
#define XB_XCNT(j)  (256  + 64 * (j))
#define XB_XSUB(j)  (1280 + 64 * (j))
#define XB_XGEN(j)  (2304 + 64 * (j))
#define XB_TOP      3328
#define XB_TOPGEN   3392
#define XCD_BAR_WORDS 3456
#define XB_SPIN_CAP (1u << 18)
#define LAS __attribute__((address_space(3)))

__device__ __forceinline__ unsigned xb_ld(unsigned* p)              { return __hip_atomic_load(p, __ATOMIC_RELAXED, __HIP_MEMORY_SCOPE_AGENT); }
__device__ __forceinline__ unsigned xb_add(unsigned* p, unsigned v) { return __hip_atomic_fetch_add(p, v, __ATOMIC_RELAXED, __HIP_MEMORY_SCOPE_AGENT); }
__device__ __forceinline__ unsigned xb_xcc_id() { return (unsigned)__builtin_amdgcn_s_getreg((3 << 11) | 20) & 0xFu; }
#define XB_SPIN(cond, bar) do { unsigned _sp = 0; while (cond) { __builtin_amdgcn_s_sleep(1); \
    if ((++_sp & 255u) == 0u) { if (xb_ld(&(bar)[XB_TMO])) break; if (_sp > XB_SPIN_CAP) { atomicAdd(&(bar)[XB_TMO], 1u); break; } } } } while (0)

struct XcdBarrier {
    unsigned* bar; unsigned x;
    volatile LAS unsigned* st;
};

__device__ __forceinline__ XcdBarrier xcd_barrier_post(unsigned* bar, volatile LAS unsigned* st) {
    XcdBarrier b; b.bar = bar; b.x = xb_xcc_id(); b.st = st;
    if (threadIdx.x == 0) (void)xb_add(&bar[XB_XCNT(b.x)], 1u);
    return b;
}
__device__ __forceinline__ void xcd_barrier_complete(unsigned* bar, unsigned x, unsigned& nloc, unsigned& nx) {
    const unsigned G = gridDim.x * gridDim.y * gridDim.z;
    unsigned sum, cnt, mine, sp = 0u;
    for (;;) {
        sum = 0u; cnt = 0u; mine = 0u;
#pragma unroll
        for (unsigned j = 0; j < 16; ++j) { const unsigned c = xb_ld(&bar[XB_XCNT(j)]); sum += c; cnt += (c > 0u) ? 1u : 0u; mine = (j == x) ? c : mine; }
        if (sum == G) break;
        __builtin_amdgcn_s_sleep(1);
        if ((++sp & 255u) == 0u) { if (xb_ld(&bar[XB_TMO])) break; if (sp > XB_SPIN_CAP) { atomicAdd(&bar[XB_TMO], 1u); break; } }
    }
    nloc = mine > 0u ? mine : 1u; nx = cnt > 0u ? cnt : 1u;
}

__device__ __forceinline__ void xcd_barrier(const XcdBarrier& b) {
    asm volatile("s_waitcnt vmcnt(0)" ::: "memory");
    __syncthreads();
    if (threadIdx.x == 0) {
        unsigned* bar = b.bar;
        __builtin_amdgcn_s_waitcnt(0);
        unsigned nloc = b.st[0], nx = b.st[1];
        if (nloc == 0u) { xcd_barrier_complete(bar, b.x, nloc, nx); b.st[0] = nloc; b.st[1] = nx; }
        const unsigned old = xb_add(&bar[XB_XSUB(b.x)], 1u);
        const unsigned gen = old / nloc;
        if (old + 1u == (gen + 1u) * nloc) {
            __builtin_amdgcn_fence(__ATOMIC_RELEASE, "agent");
            asm volatile("s_waitcnt vmcnt(0)" ::: "memory");
            const unsigned og = xb_add(&bar[XB_TOP], 1u);
            const unsigned tg = og / nx;
            if (og + 1u == (tg + 1u) * nx) xb_add(&bar[XB_TOPGEN], 1u);
            else XB_SPIN(xb_ld(&bar[XB_TOPGEN]) == tg, bar);
            __builtin_amdgcn_fence(__ATOMIC_ACQUIRE, "agent");
            xb_add(&bar[XB_XGEN(b.x)], 1u);
            asm volatile("s_waitcnt vmcnt(0)" ::: "memory");
        } else {
            XB_SPIN(xb_ld(&bar[XB_XGEN(b.x)]) == gen, bar);
            __builtin_amdgcn_fence(__ATOMIC_ACQUIRE, "agent");
            asm volatile("s_waitcnt vmcnt(0)" ::: "memory");
        }
    }
    __syncthreads();
}
#include <hip/hip_runtime.h>
namespace pg8 {
#define PG8_LAS __attribute__((address_space(3)))
typedef unsigned short bf16_t;
typedef short bf16x8 __attribute__((ext_vector_type(8)));
typedef float f32x4 __attribute__((ext_vector_type(4)));
typedef unsigned u32x4 __attribute__((ext_vector_type(4)));
constexpr int BM = 256, BK = 64, HALF = 128, HTB = HALF * BK * 2  , STAGE_BYTES = 8 * HTB, NXCD = 8, WGM = 8;

__host__ __device__ __forceinline__ int lds_byte(int r, int c) { const int st = (r >> 4) * 2 + (c >> 5), rr = r & 15, cc = c & 31, ob = rr * 64 + cc * 2; return st * 1024 + (ob ^ (((ob >> 9) & 1) << 5)); }
__host__ __device__ __forceinline__ void stage_rc(int b, int& R, int& C) { const int st = b / 1024, sb = b % 1024, swz = sb ^ (((sb >> 9) & 1) << 5); R = (st >> 1) * 16 + swz / 64; C = (st & 1) * 32 + (swz % 64) / 2; }
__host__ __device__ __forceinline__ int perm32(int rho) { const int n = rho >> 4, i = rho & 15; return 8 * (i >> 2) + 4 * n + (i & 3); }

struct Unit { int pm, pn; };
struct Gemm { const bf16_t* A; const bf16_t* Bt; int M, N, K; };

struct StaticOrder {
    int nM, nN, nwg, G, c;
    __host__ __device__ void init(int M, int N, int G_, int c_) { nM = M / BM; nN = N / BM; nwg = nM * nN; G = G_; c = c_; }
    __host__ __device__ bool next(int i, Unit& u) const {
        const long L = (long)i * G + c; if (L >= nwg) return false;
        int wgid = (int)L; { const int q = nwg / NXCD, r = nwg % NXCD, xcd = wgid % NXCD, off = wgid / NXCD; wgid = (xcd < r ? xcd * (q + 1) : r * (q + 1) + (xcd - r) * q) + off; }
        const int nig = WGM * nN, gid = wgid / nig, fm = gid * WGM, gsz = (nM - fm) < WGM ? (nM - fm) : WGM;
        u.pm = fm + ((wgid % nig) % gsz); u.pn = (wgid % nig) / gsz; return true;
    }
    __device__ __forceinline__ void a_ready(const Unit&) const {}
    __device__ __forceinline__ void done(const Unit&) const {}
};
__device__ __forceinline__ unsigned cvt_pk_bf16(float lo, float hi) { unsigned r; asm volatile("v_cvt_pk_bf16_f32 %0, %1, %2" : "=v"(r) : "v"(lo), "v"(hi)); return r; }
struct EpiF32 {
    static constexpr bool PERM = false, AFTER_DRAIN = false;
    float* C; int ldc; const float* bias;
    __device__ __forceinline__ void operator()(const f32x4 (&acc)[2][2][4][2], const Unit& u, int wr, int wc, int fr, int fq) const {
        const int row0 = u.pm * BM + wr * 64 + fr, col0 = u.pn * BM + wc * 32 + 4 * fq;
        f32x4 bv[2][2];
#pragma unroll
        for (int bj = 0; bj < 2; ++bj)
#pragma unroll
            for (int n = 0; n < 2; ++n) bv[bj][n] = bias ? *(const f32x4*)(bias + col0 + bj * HALF + n * 16) : (f32x4){0.f, 0.f, 0.f, 0.f};
#pragma unroll
        for (int ai = 0; ai < 2; ++ai)
#pragma unroll
            for (int m = 0; m < 4; ++m) { float* rowp = C + (size_t)(row0 + ai * HALF + m * 16) * ldc + col0;
#pragma unroll
                for (int bj = 0; bj < 2; ++bj)
#pragma unroll
                    for (int n = 0; n < 2; ++n) *(f32x4*)(rowp + bj * HALF + n * 16) = acc[ai][bj][m][n] + bv[bj][n]; }
    }
};
typedef unsigned u32x2 __attribute__((ext_vector_type(2)));
struct EpiBf16P {
    static constexpr bool PERM = true, AFTER_DRAIN = false;
    bf16_t* O; int ldc;
    __device__ __forceinline__ void operator()(const f32x4 (&acc)[2][2][4][2], const Unit& u, int wr, int wc, int fr, int fq) const {
        const int row0 = u.pm * BM + wr * 64 + fr, col0 = u.pn * BM + wc * 32 + 8 * fq;
#pragma unroll
        for (int ai = 0; ai < 2; ++ai)
#pragma unroll
            for (int m = 0; m < 4; ++m) { bf16_t* rowp = O + (size_t)(row0 + ai * HALF + m * 16) * ldc + col0;
#pragma unroll
                for (int bj = 0; bj < 2; ++bj) { const f32x4 v0 = acc[ai][bj][m][0], v1 = acc[ai][bj][m][1];
                    u32x4 w; w.x = cvt_pk_bf16(v0[0], v0[1]); w.y = cvt_pk_bf16(v0[2], v0[3]); w.z = cvt_pk_bf16(v1[0], v1[1]); w.w = cvt_pk_bf16(v1[2], v1[3]);
                    *(u32x4*)(rowp + bj * HALF) = w; } }
    }
};
__device__ __forceinline__ float silu_mul(float g, float u) { return g * u * __builtin_amdgcn_rcpf(1.0f + __expf(-g)); }
struct EpiSwiGLU {
    static constexpr bool PERM = true, AFTER_DRAIN = false;
    bf16_t* O; int ldc;
    __device__ __forceinline__ void operator()(const f32x4 (&acc)[2][2][4][2], const Unit& u, int wr, int wc, int fr, int fq) const {
        const int row0 = u.pm * BM + wr * 64 + fr, col0 = u.pn * HALF + wc * 32 + 8 * fq;
#pragma unroll
        for (int ai = 0; ai < 2; ++ai)
#pragma unroll
            for (int m = 0; m < 4; ++m) { bf16_t* rowp = O + (size_t)(row0 + ai * HALF + m * 16) * ldc + col0;
                const f32x4 g0 = acc[ai][0][m][0], g1 = acc[ai][0][m][1], u0 = acc[ai][1][m][0], u1 = acc[ai][1][m][1];
                u32x4 w; w.x = cvt_pk_bf16(silu_mul(g0[0], u0[0]), silu_mul(g0[1], u0[1])); w.y = cvt_pk_bf16(silu_mul(g0[2], u0[2]), silu_mul(g0[3], u0[3]));
                w.z = cvt_pk_bf16(silu_mul(g1[0], u1[0]), silu_mul(g1[1], u1[1])); w.w = cvt_pk_bf16(silu_mul(g1[2], u1[2]), silu_mul(g1[3], u1[3]));
                *(u32x4*)rowp = w; }
    }
};

template <class Epi, class Sched, bool ALIGN_EPI = false, bool SP2 = false>
__device__ __forceinline__ void gemm_phase(PG8_LAS unsigned char* lds, const Gemm g, const Sched& S, const Epi& E) {
    int tid_l = threadIdx.x; asm volatile("" : "+v"(tid_l));
    const int tid = tid_l, wid = __builtin_amdgcn_readfirstlane(tid >> 6), lane = tid & 63, wr = wid >> 2, wc = wid & 3, fr = lane & 15, fq = lane >> 4;
    const int K = g.K, nt = K / BK;
    unsigned voffA[2], voffB[2];
#pragma unroll
    for (int i = 0; i < 2; ++i) { int R, C; stage_rc(tid * 16 + i * 8192, R, C); const int Rb = Epi::PERM ? ((R & ~31) + perm32(R & 31)) : R;
        voffA[i] = (unsigned)(R * K + C) * 2u; voffB[i] = (unsigned)(Rb * K + C) * 2u; }
    const size_t kstep = (size_t)(BK * 2);
    const size_t hstep = (size_t)HALF * K * 2;
    const size_t tstep = 2 * hstep;
    const unsigned ldsw = (unsigned)wid * 1024u;
    const int aoff = lds_byte(wr * 64 + fr, fq * 8), boff = lds_byte(wc * 32 + fr, fq * 8);
#define PG8_SA(b, h) (((b) * 2 + (h)) * HTB)
#define PG8_SB(b, h) ((4 + (b) * 2 + (h)) * HTB)
#define PG8_STAGE(bufoff, gbase, voff) do { _Pragma("unroll") for (int _i = 0; _i < 2; ++_i) \
        __builtin_amdgcn_global_load_lds((const unsigned*)((const char*)(gbase) + (voff)[_i]), (PG8_LAS unsigned*)(lds + (bufoff) + ldsw + _i * 8192), 16, 0, 0); } while (0)
#define PG8_LDA(dst, b, h) do { _Pragma("unroll") for (int m = 0; m < 4; ++m) _Pragma("unroll") for (int k = 0; k < 2; ++k) dst[m][k] = *(const PG8_LAS bf16x8*)(lds + PG8_SA(b, h) + aoff + m * 2048 + k * 1024); } while (0)
#define PG8_LDB(dst, b, h) do { _Pragma("unroll") for (int n = 0; n < 2; ++n) _Pragma("unroll") for (int k = 0; k < 2; ++k) dst[n][k] = *(const PG8_LAS bf16x8*)(lds + PG8_SB(b, h) + boff + n * 2048 + k * 1024); } while (0)
#define PG8_MMA(ai, bj, At, Bt) do { __builtin_amdgcn_s_setprio(1); _Pragma("unroll") for (int m = 0; m < 4; ++m) _Pragma("unroll") for (int n = 0; n < 2; ++n) _Pragma("unroll") for (int k = 0; k < 2; ++k) \
        acc[ai][bj][m][n] = __builtin_amdgcn_mfma_f32_16x16x32_bf16(Bt[n][k], At[m][k], acc[ai][bj][m][n], 0, 0, 0); __builtin_amdgcn_s_setprio(0); } while (0)
#define PG8_WAIT_V(n) asm volatile("s_waitcnt vmcnt(" #n ")" ::: "memory")
#define PG8_WAIT_L(n) asm volatile("s_waitcnt lgkmcnt(" #n ")" ::: "memory")
#define PG8_BAR __builtin_amdgcn_s_barrier()
#define PG8_SCHED __builtin_amdgcn_sched_barrier(0)
    Unit cur, nxt; int ui = 0;
    if (!S.next(0, cur)) return;
    f32x4 acc[2][2][4][2];
#pragma unroll
    for (int a = 0; a < 2; ++a)
#pragma unroll
        for (int b = 0; b < 2; ++b)
#pragma unroll
            for (int m = 0; m < 4; ++m)
#pragma unroll
                for (int n = 0; n < 2; ++n) acc[a][b][m][n] = (f32x4){0.f, 0.f, 0.f, 0.f};
    bf16x8 At[4][2], B0[2][2], B1[2][2];
    const char* cA = (const char*)g.A + (size_t)cur.pm * tstep; const char* cB = (const char*)g.Bt + (size_t)cur.pn * tstep;
    S.a_ready(cur);
    if constexpr (SP2) {
        PG8_STAGE(PG8_SB(0, 0), cB, voffB); PG8_STAGE(PG8_SB(0, 1), cB + hstep, voffB); PG8_STAGE(PG8_SA(0, 0), cA, voffA); PG8_STAGE(PG8_SA(0, 1), cA + hstep, voffA);
        if (wr == 1) PG8_BAR;
        PG8_WAIT_V(2); PG8_BAR;
        PG8_STAGE(PG8_SB(1, 0), cB + kstep, voffB); PG8_STAGE(PG8_SA(1, 0), cA + kstep, voffA); PG8_STAGE(PG8_SB(1, 1), cB + hstep + kstep, voffB);
        PG8_WAIT_V(6); PG8_BAR;
    } else {
        PG8_STAGE(PG8_SB(0, 0), cB, voffB); PG8_STAGE(PG8_SA(0, 0), cA, voffA); PG8_STAGE(PG8_SB(0, 1), cB + hstep, voffB); PG8_STAGE(PG8_SA(0, 1), cA + hstep, voffA);
        if (wr == 1) PG8_BAR;
        PG8_WAIT_V(4); PG8_BAR;
        PG8_STAGE(PG8_SB(1, 0), cB + kstep, voffB); PG8_STAGE(PG8_SA(1, 0), cA + kstep, voffA); PG8_STAGE(PG8_SB(1, 1), cB + hstep + kstep, voffB);
        PG8_WAIT_V(6); PG8_BAR;
    }
    for (;;) {
        const bool has_next = S.next(ui + 1, nxt);
        const char* nA = has_next ? (const char*)g.A + (size_t)nxt.pm * tstep : cA; const char* nB = has_next ? (const char*)g.Bt + (size_t)nxt.pn * tstep : cB;
        for (int t = 0; t < nt; t += 2) {
            const bool last = (t == nt - 2);
            const char* a1 = cA + (size_t)(t + 1) * kstep;
            const char* a2 = last ? nA : cA + (size_t)(t + 2) * kstep; const char* b2 = last ? nB : cB + (size_t)(t + 2) * kstep;
            const char* a3 = a2 + kstep; const char* b3 = b2 + kstep;
            if (last && has_next) S.a_ready(nxt);
            if constexpr (SP2) {
            PG8_LDB(B0, 0, 0); PG8_LDB(B1, 0, 1); PG8_SCHED; PG8_LDA(At, 0, 0); PG8_STAGE(PG8_SA(1, 1), a1 + hstep, voffA);
            PG8_WAIT_V(8); PG8_WAIT_L(0); PG8_BAR; PG8_MMA(0, 0, At, B0); PG8_MMA(0, 1, At, B1); PG8_BAR; PG8_SCHED;
            PG8_LDA(At, 0, 1); PG8_STAGE(PG8_SB(0, 0), b2, voffB); PG8_STAGE(PG8_SB(0, 1), b2 + hstep, voffB); PG8_STAGE(PG8_SA(0, 0), a2, voffA);
            PG8_WAIT_V(8); PG8_WAIT_L(0); PG8_BAR; PG8_MMA(1, 0, At, B0); PG8_MMA(1, 1, At, B1); PG8_BAR; PG8_SCHED;
            PG8_LDB(B0, 1, 0); PG8_LDB(B1, 1, 1); PG8_SCHED; PG8_LDA(At, 1, 0); PG8_STAGE(PG8_SA(0, 1), a2 + hstep, voffA);
            PG8_WAIT_V(8); PG8_WAIT_L(0); PG8_BAR; PG8_MMA(0, 0, At, B0); PG8_MMA(0, 1, At, B1); PG8_BAR; PG8_SCHED;
            PG8_LDA(At, 1, 1); PG8_STAGE(PG8_SB(1, 0), b3, voffB); PG8_STAGE(PG8_SB(1, 1), b3 + hstep, voffB); PG8_STAGE(PG8_SA(1, 0), a3, voffA);
            PG8_WAIT_V(8); PG8_WAIT_L(0); PG8_BAR; PG8_MMA(1, 0, At, B0); PG8_MMA(1, 1, At, B1); PG8_BAR; PG8_SCHED;
            } else {
            PG8_LDB(B0, 0, 0); PG8_SCHED; PG8_LDA(At, 0, 0); PG8_STAGE(PG8_SA(1, 1), a1 + hstep, voffA);
            PG8_WAIT_L(8); PG8_BAR; PG8_WAIT_L(0); PG8_MMA(0, 0, At, B0); PG8_BAR; PG8_SCHED;
            PG8_LDB(B1, 0, 1); PG8_STAGE(PG8_SB(0, 0), b2, voffB);
            PG8_BAR; PG8_WAIT_L(0); PG8_MMA(0, 1, At, B1); PG8_BAR;
            PG8_LDA(At, 0, 1); PG8_STAGE(PG8_SA(0, 0), a2, voffA);
            PG8_BAR; PG8_WAIT_L(0); PG8_MMA(1, 0, At, B0); PG8_BAR; PG8_SCHED;
            PG8_STAGE(PG8_SB(0, 1), b2 + hstep, voffB);
            PG8_WAIT_V(6); PG8_BAR; PG8_MMA(1, 1, At, B1); PG8_BAR;
            PG8_LDB(B0, 1, 0); PG8_SCHED; PG8_LDA(At, 1, 0); PG8_STAGE(PG8_SA(0, 1), a2 + hstep, voffA);
            PG8_WAIT_L(8); PG8_BAR; PG8_WAIT_L(0); PG8_MMA(0, 0, At, B0); PG8_BAR; PG8_SCHED;
            PG8_LDB(B1, 1, 1); PG8_STAGE(PG8_SB(1, 0), b3, voffB);
            PG8_BAR; PG8_WAIT_L(0); PG8_MMA(0, 1, At, B1); PG8_BAR;
            PG8_LDA(At, 1, 1); PG8_STAGE(PG8_SA(1, 0), a3, voffA);
            PG8_BAR; PG8_WAIT_L(0); PG8_MMA(1, 0, At, B0); PG8_BAR; PG8_SCHED;
            PG8_STAGE(PG8_SB(1, 1), b3 + hstep, voffB);
            PG8_WAIT_V(6); PG8_BAR; PG8_MMA(1, 1, At, B1); PG8_BAR;
            }
        }
        if constexpr (ALIGN_EPI) { if (wr == 0) PG8_BAR; }
        if constexpr (!Epi::AFTER_DRAIN) { E(acc, cur, wr, wc, fr, fq); S.done(cur); }
        if (!has_next) break;
#pragma unroll
        for (int a = 0; a < 2; ++a)
#pragma unroll
            for (int b = 0; b < 2; ++b)
#pragma unroll
                for (int m = 0; m < 4; ++m)
#pragma unroll
                    for (int n = 0; n < 2; ++n) acc[a][b][m][n] = (f32x4){0.f, 0.f, 0.f, 0.f};
        cur = nxt; cA = nA; cB = nB; ++ui;
        if constexpr (ALIGN_EPI) { if (wr == 1) PG8_BAR; }
    }
    PG8_WAIT_V(0);
    if constexpr (!ALIGN_EPI) { if (wr == 0) PG8_BAR; }
    PG8_BAR;
    if constexpr (Epi::AFTER_DRAIN) { E.fused(acc, cur, wr, wc, fr, fq, lds, wid, lane); S.done(cur); }
#undef PG8_SA
#undef PG8_SB
#undef PG8_STAGE
#undef PG8_LDA
#undef PG8_LDB
#undef PG8_MMA
#undef PG8_WAIT_V
#undef PG8_WAIT_L
#undef PG8_BAR
#undef PG8_SCHED
}
}

using pg8::bf16_t; using pg8::bf16x8; using pg8::f32x4; using pg8::u32x4; using pg8::u32x2; using pg8::cvt_pk_bf16;

constexpr int S_ = 16384, D_ = 2048, DFF_ = 5632, INW_ = 4608, DEPTH_ = 2;
constexpr int LDS_BYTES = 131072 + 16;
constexpr size_t SZ_WIN = (size_t)2 * DFF_ * D_ * 2, SZ_WOUT = (size_t)D_ * DFF_ * 2, SZ_WMIN = (size_t)INW_ * D_ * 2, SZ_WMOUT = (size_t)D_ * D_ * 2;
constexpr size_t OFF_W1IN = 0, OFF_W1OUT = OFF_W1IN + SZ_WIN, OFF_WMIN = OFF_W1OUT + SZ_WOUT, OFF_WMOUT = OFF_WMIN + SZ_WMIN, OFF_W2IN = OFF_WMOUT + SZ_WMOUT, OFF_W2OUT = OFF_W2IN + SZ_WIN;
constexpr size_t OFF_POOLW = OFF_W2OUT + SZ_WOUT, OFF_GATEW = OFF_POOLW + 131072, OFF_LSUM = OFF_GATEW + 131072;
constexpr size_t OFF_XN = OFF_LSUM + 524288, OFF_HID = OFF_XN + (size_t)S_ * D_ * 2, OFF_H = OFF_HID + (size_t)S_ * DFF_ * 2, OFF_Y = OFF_H + (size_t)S_ * D_ * 2, OFF_BAR = OFF_Y + (size_t)S_ * D_ * 2, WS_END = OFF_BAR + 16384;
constexpr int NPHASE = 1 + 11 * DEPTH_;

struct Params { const float* in[15]; float* out; unsigned char* ws; };

__device__ __forceinline__ int ltid() { int t = threadIdx.x; asm volatile("" : "+v"(t)); return t; }
__device__ __forceinline__ float bf2f(unsigned short b) { return __uint_as_float(((unsigned)b) << 16); }
__device__ __forceinline__ float wave_sum(float v) {
#pragma unroll
    for (int o = 32; o > 0; o >>= 1) v += __shfl_xor(v, o);
    return v;
}

__device__ __forceinline__ void convert_tile(LAS unsigned char* lds, const float* __restrict__ src, bf16_t* __restrict__ dst, int K, int srcN, int perm, int nt_idx, int kt_idx, int tid) {
    const int n = tid & 63, kg = tid >> 6;
    const int np0 = nt_idx * 64;
    int sc0 = np0;
    if (perm) { const int pn = np0 >> 8, bj = (np0 >> 7) & 1, j = np0 & 127; sc0 = bj * DFF_ + pn * 128 + j; }
    const float* s = src + (size_t)(kt_idx * 128 + kg * 16) * srcN + sc0 + n;
    float v[16];
#pragma unroll
    for (int i = 0; i < 16; ++i) v[i] = __builtin_nontemporal_load(s + (size_t)i * srcN);
#pragma unroll
    for (int i = 0; i < 4; ++i) { u32x2 w; w.x = cvt_pk_bf16(v[i * 4], v[i * 4 + 1]); w.y = cvt_pk_bf16(v[i * 4 + 2], v[i * 4 + 3]);
        *(LAS u32x2*)(lds + n * 264 + (kg * 4 + i) * 8) = w; }
    __syncthreads();
#pragma unroll
    for (int pass = 0; pass < 2; ++pass) { const int row = pass * 32 + (tid >> 4), c = tid & 15;
        const u32x2 a = *(const LAS u32x2*)(lds + row * 264 + c * 16), b = *(const LAS u32x2*)(lds + row * 264 + c * 16 + 8);
        u32x4 o; o.x = a.x; o.y = a.y; o.z = b.x; o.w = b.y;
        *(u32x4*)(dst + (size_t)(np0 + row) * K + kt_idx * 128 + c * 8) = o; }
    __syncthreads();
}

__device__ __forceinline__ void convert_phase(LAS unsigned char* lds, const Params& p, int layer) {
    unsigned char* ws = p.ws; const int tid = ltid();
    const int ntiles[6] = {2816, 1408, 1152, 512, 2816, 1408};
    int total = 0;
#pragma unroll
    for (int j = 0; j < 6; ++j) total += ntiles[j];
    for (int T = blockIdx.x; T < total; T += gridDim.x) {
        int loc = T; int job = 0;
#pragma unroll
        for (int j = 0; j < 5; ++j) if (job == j && loc >= ntiles[j]) { loc -= ntiles[j]; job = j + 1; }
        const float* src; bf16_t* dst; int K, srcN, perm, ntn;
        switch (job) {
            case 0: src = p.in[2] + (size_t)layer * D_ * 2 * DFF_; dst = (bf16_t*)(ws + OFF_W1IN); K = D_; srcN = 2 * DFF_; perm = 1; ntn = 2 * DFF_ / 64; break;
            case 1: src = p.in[3] + (size_t)layer * DFF_ * D_; dst = (bf16_t*)(ws + OFF_W1OUT); K = DFF_; srcN = D_; perm = 0; ntn = D_ / 64; break;
            case 2: src = p.in[4] + (size_t)layer * D_ * INW_; dst = (bf16_t*)(ws + OFF_WMIN); K = D_; srcN = INW_; perm = 0; ntn = INW_ / 64; break;
            case 3: src = p.in[5] + (size_t)layer * D_ * D_; dst = (bf16_t*)(ws + OFF_WMOUT); K = D_; srcN = D_; perm = 0; ntn = D_ / 64; break;
            case 4: src = p.in[13] + (size_t)layer * D_ * 2 * DFF_; dst = (bf16_t*)(ws + OFF_W2IN); K = D_; srcN = 2 * DFF_; perm = 1; ntn = 2 * DFF_ / 64; break;
            default: src = p.in[14] + (size_t)layer * DFF_ * D_; dst = (bf16_t*)(ws + OFF_W2OUT); K = DFF_; srcN = D_; perm = 0; ntn = D_ / 64; break;
        }
        const int kt = loc / ntn, nt = loc - kt * ntn;
        convert_tile(lds, src, dst, K, srcN, perm, nt, kt, tid);
    }
    const float* pw = p.in[6] + (size_t)layer * 65536; const float* gw = p.in[10] + (size_t)layer * 65536;
    bf16_t* pwt = (bf16_t*)(ws + OFF_POOLW); bf16_t* gwt = (bf16_t*)(ws + OFF_GATEW);
    for (int i = blockIdx.x * 512 + tid; i < 131072; i += gridDim.x * 512) {
        if (i < 65536) { const int g = i >> 14, d = (i >> 7) & 127, c = i & 127; pwt[i] = (bf16_t)(cvt_pk_bf16(pw[(g * 128 + c) * 128 + d], 0.f) & 0xffffu); }
        else { const int k = i - 65536; const int gh = k >> 12, d = (k >> 6) & 63, c = k & 63; gwt[k] = (bf16_t)(cvt_pk_bf16(gw[(gh * 64 + c) * 64 + d], 0.f) & 0xffffu); }
    }
}

__device__ __forceinline__ void norm_phase(const bf16_t* __restrict__ h, const float* xs, float* xd, float coef, const float* __restrict__ ga, const float* __restrict__ gb, bf16_t* __restrict__ xn) {
    const int tid = ltid(); const int lane = tid & 63, gwv = blockIdx.x * 8 + (tid >> 6), GW = gridDim.x * 8;
    for (int row = gwv; row < S_; row += GW) {
        f32x4 xv[8];
        const f32x4* xr = (const f32x4*)(xs + (size_t)row * D_);
#pragma unroll
        for (int i = 0; i < 8; ++i) xv[i] = xr[lane + i * 64];
        if (h) {
            f32x4 hv[8]; const u32x2* hr = (const u32x2*)(h + (size_t)row * D_); float ss = 0.f;
#pragma unroll
            for (int i = 0; i < 8; ++i) { const u32x2 hw = hr[lane + i * 64]; hv[i] = (f32x4){__uint_as_float(hw.x << 16), __uint_as_float(hw.x & 0xffff0000u), __uint_as_float(hw.y << 16), __uint_as_float(hw.y & 0xffff0000u)}; ss += hv[i][0] * hv[i][0] + hv[i][1] * hv[i][1] + hv[i][2] * hv[i][2] + hv[i][3] * hv[i][3]; }
            ss = wave_sum(ss);
            const float rs = coef * rsqrtf(ss * (1.0f / D_) + 1e-6f);
            f32x4* xw = (f32x4*)(xd + (size_t)row * D_);
#pragma unroll
            for (int i = 0; i < 8; ++i) { const f32x4 g = ((const f32x4*)ga)[lane + i * 64]; xv[i] = xv[i] + hv[i] * g * rs; xw[lane + i * 64] = xv[i]; }
        }
        if (xn) {
            float ss = 0.f;
#pragma unroll
            for (int i = 0; i < 8; ++i) ss += xv[i][0] * xv[i][0] + xv[i][1] * xv[i][1] + xv[i][2] * xv[i][2] + xv[i][3] * xv[i][3];
            ss = wave_sum(ss);
            const float rs = rsqrtf(ss * (1.0f / D_) + 1e-6f);
            u32x2* xo = (u32x2*)(xn + (size_t)row * D_);
#pragma unroll
            for (int i = 0; i < 8; ++i) { const f32x4 g = ((const f32x4*)gb)[lane + i * 64]; const f32x4 y = xv[i] * g * rs; u32x2 w; w.x = cvt_pk_bf16(y[0], y[1]); w.y = cvt_pk_bf16(y[2], y[3]); xo[lane + i * 64] = w; }
        }
    }
}

#define MFMA16(a, b, c) __builtin_amdgcn_mfma_f32_16x16x32_bf16((a), (b), (c), 0, 0, 0)

typedef short s16x4 __attribute__((ext_vector_type(4)));
__device__ __forceinline__ void attn_chunk_geom(int ci, int P0, int& kb, int& sh) {
    if (ci < 12) { sh = 0; kb = P0 - 128 + ci * 32; } else if (ci < 18) { sh = 2; kb = P0 - 512 + ((ci - 12) * 32) * 4; } else { sh = 4; kb = P0 - 2048 + ((ci - 18) * 32) * 16; }
}
__device__ __forceinline__ void attn_load(const bf16_t* __restrict__ zk, const bf16_t* __restrict__ zv, int kb, int sh, int fr, int lane, bf16x8 (&kq)[4], bf16x8 (&vq)[4]) {
#pragma unroll
    for (int t = 0; t < 2; ++t) { int kp = kb + ((t * 16 + fr) << sh); kp = kp < 0 ? 0 : (kp > S_ - 1 ? S_ - 1 : kp);
        const bf16_t* kr = zk + (size_t)kp * INW_; kq[t * 2] = *(const bf16x8*)kr; kq[t * 2 + 1] = *(const bf16x8*)(kr + 32); }
#pragma unroll
    for (int i = 0; i < 4; ++i) { int kp = kb + ((i * 8 + (lane >> 3)) << sh); kp = kp < 0 ? 0 : (kp > S_ - 1 ? S_ - 1 : kp);
        vq[i] = *(const bf16x8*)(zv + (size_t)kp * INW_); }
}
__device__ __forceinline__ void attn_item(LAS unsigned char* vl, const bf16_t* __restrict__ z, bf16_t* __restrict__ y, int item, int lane) {
    const int fr = lane & 15, fq = lane >> 4;
    const int Bblk = item >> 8, head = (item >> 4) & 15, r = item & 15;
    const int P0 = Bblk * 256 + r, pq = P0 + 16 * fr;
    const float slope = exp2f(-0.5f * (float)(head + 1));
    const bf16_t* zq = z + (size_t)pq * INW_ + 1536 + head * 64 + fq * 8;
    const bf16x8 qf0 = *(const bf16x8*)zq, qf1 = *(const bf16x8*)(zq + 32);
    const bf16_t* zk = z + 2560 + head * 64 + fq * 8;
    const bf16_t* zv = z + 3584 + head * 64 + (lane & 7) * 8;
    LAS unsigned char* vst = vl + (lane >> 3) * 144 + (lane & 7) * 16;
    LAS unsigned char* vrd = vl + (fq * 4 + (fr >> 2)) * 144 + (fr & 3) * 8;
    float m = -1e30f, l = 0.f;
    f32x4 o[4];
#pragma unroll
    for (int i = 0; i < 4; ++i) o[i] = (f32x4){0.f, 0.f, 0.f, 0.f};
    bf16x8 kq[4], vq[4];
    int kb, sh; attn_chunk_geom(0, P0, kb, sh);
    attn_load(zk, zv, kb, sh, fr, lane, kq, vq);
#pragma unroll 1
    for (int ci = 0; ci < 23; ++ci) {
        bf16x8 kn[4], vn[4]; int kbn, shn;
        attn_chunk_geom(ci + 1 < 23 ? ci + 1 : 22, P0, kbn, shn);
        attn_load(zk, zv, kbn, shn, fr, lane, kn, vn);
#pragma unroll
        for (int i = 0; i < 4; ++i) *(LAS bf16x8*)(vst + i * 8 * 144) = vq[i];
        f32x4 st[2];
#pragma unroll
        for (int t = 0; t < 2; ++t) { st[t] = MFMA16(kq[t * 2], qf0, ((f32x4){0.f, 0.f, 0.f, 0.f})); st[t] = MFMA16(kq[t * 2 + 1], qf1, st[t]); }
        const int wmax = 128 << sh;
        float sv[8]; bool ok[8]; float cmax = -1e30f;
#pragma unroll
        for (int i = 0; i < 8; ++i) {
            const int kp = kb + (((i >> 2) * 16 + fq * 4 + (i & 3)) << sh), delta = pq - kp;
            ok[i] = (delta >= 0) && (delta <= wmax) && (kp >= 0);
            sv[i] = ok[i] ? st[i >> 2][i & 3] * 0.125f - slope * (float)delta : -1e30f;
            cmax = fmaxf(cmax, sv[i]);
        }
        cmax = fmaxf(cmax, __shfl_xor(cmax, 16)); cmax = fmaxf(cmax, __shfl_xor(cmax, 32));
        const float mn = fmaxf(m, cmax), alpha = __expf(m - mn);
        m = mn;
        float ps = 0.f; float pv[8];
#pragma unroll
        for (int i = 0; i < 8; ++i) { pv[i] = ok[i] ? __expf(sv[i] - mn) : 0.f; ps += pv[i]; }
        l = l * alpha + ps;
        u32x4 pw; pw.x = cvt_pk_bf16(pv[0], pv[1]); pw.y = cvt_pk_bf16(pv[2], pv[3]); pw.z = cvt_pk_bf16(pv[4], pv[5]); pw.w = cvt_pk_bf16(pv[6], pv[7]);
        const bf16x8 pf = __builtin_bit_cast(bf16x8, pw);
#pragma unroll
        for (int dvt = 0; dvt < 4; ++dvt) {
            const s16x4 lo = __builtin_amdgcn_ds_read_tr16_b64_v4i16((LAS s16x4*)(vrd + dvt * 32));
            const s16x4 hi = __builtin_amdgcn_ds_read_tr16_b64_v4i16((LAS s16x4*)(vrd + 16 * 144 + dvt * 32));
            const bf16x8 vf = (bf16x8){lo[0], lo[1], lo[2], lo[3], hi[0], hi[1], hi[2], hi[3]};
            o[dvt] = o[dvt] * alpha; o[dvt] = MFMA16(vf, pf, o[dvt]);
        }
#pragma unroll
        for (int i = 0; i < 4; ++i) { kq[i] = kn[i]; vq[i] = vn[i]; }
        kb = kbn; sh = shn;
    }
    l += __shfl_xor(l, 16); l += __shfl_xor(l, 32);
    const float inv = 1.0f / l;
    bf16_t* yo = y + (size_t)pq * D_ + 1024 + head * 64 + fq * 4;
#pragma unroll
    for (int dvt = 0; dvt < 4; ++dvt) { u32x2 w; w.x = cvt_pk_bf16(o[dvt][0] * inv, o[dvt][1] * inv); w.y = cvt_pk_bf16(o[dvt][2] * inv, o[dvt][3] * inv); *(u32x2*)(yo + dvt * 16) = w; }
}

__device__ __forceinline__ void pool_item(const bf16_t* __restrict__ z, bf16_t* __restrict__ y, const bf16_t* __restrict__ pwt, const float* __restrict__ scale, int item, int lane) {
    const int fr = lane & 15, fq = lane >> 4;
    const int gi = item & 3, tt = item >> 2, t = tt * 16 + fr, win = 2 << gi;
    const float invn = 1.0f / (float)((t + 1) < win ? (t + 1) : win);
    bf16x8 pf[4];
#pragma unroll
    for (int kk = 0; kk < 4; ++kk) {
        const bf16_t* zc = z + gi * 128 + kk * 32 + fq * 8;
        float s[8];
#pragma unroll
        for (int e = 0; e < 8; ++e) s[e] = 0.f;
        const bf16x8 self = *(const bf16x8*)(zc + (size_t)t * INW_);
        for (int j = 0; j < win; ++j) { const int tj = t - j; if (tj >= 0) { const bf16x8 v = *(const bf16x8*)(zc + (size_t)tj * INW_);
#pragma unroll
                for (int e = 0; e < 8; ++e) s[e] += bf2f((unsigned short)v[e]); } }
        u32x4 w;
        w.x = cvt_pk_bf16(s[0] * invn - bf2f((unsigned short)self[0]), s[1] * invn - bf2f((unsigned short)self[1]));
        w.y = cvt_pk_bf16(s[2] * invn - bf2f((unsigned short)self[2]), s[3] * invn - bf2f((unsigned short)self[3]));
        w.z = cvt_pk_bf16(s[4] * invn - bf2f((unsigned short)self[4]), s[5] * invn - bf2f((unsigned short)self[5]));
        w.w = cvt_pk_bf16(s[6] * invn - bf2f((unsigned short)self[6]), s[7] * invn - bf2f((unsigned short)self[7]));
        pf[kk] = __builtin_bit_cast(bf16x8, w);
    }
    const bf16_t* wb = pwt + (size_t)gi * 16384 + fr * 128 + fq * 8;
    bf16_t* yo = y + (size_t)t * D_ + gi * 128 + fq * 4;
    const float* sc = scale + gi * 128 + fq * 4;
#pragma unroll
    for (int dt = 0; dt < 8; ++dt) {
        f32x4 acc = (f32x4){0.f, 0.f, 0.f, 0.f};
#pragma unroll
        for (int kk = 0; kk < 4; ++kk) { const bf16x8 wf = *(const bf16x8*)(wb + dt * 16 * 128 + kk * 32); acc = MFMA16(wf, pf[kk], acc); }
        const f32x4 s4 = *(const f32x4*)(sc + dt * 16);
        u32x2 w; w.x = cvt_pk_bf16(acc[0] * s4[0], acc[1] * s4[1]); w.y = cvt_pk_bf16(acc[2] * s4[2], acc[3] * s4[3]);
        *(u32x2*)(yo + dt * 16) = w;
    }
}

__device__ __forceinline__ void lru_item(LAS unsigned char* wlds, const bf16_t* __restrict__ z, const Params& p, int layer, const bf16_t* __restrict__ gwt,
                                         float* __restrict__ HL, float* __restrict__ PC, float* __restrict__ sumP, float* __restrict__ sumH, int item, int lane) {
    const int fr = lane & 15, fq = lane >> 4;
    const int hh = item & 7, ck = item >> 3, T0 = ck * 128;
    const float* convw = p.in[8] + (size_t)layer * 4 * 512 + hh * 64;
    const float* convb = p.in[9] + (size_t)layer * 512 + hh * 64;
    const float* gb = p.in[11] + (size_t)layer * 1024;
    const float* lam = p.in[12] + (size_t)layer * 512 + hh * 64;
    LAS float* Al = (LAS float*)wlds; LAS float* Gl = (LAS float*)(wlds + 4224);
    float br_[4], bi_[4], sp_[4];
#pragma unroll
    for (int nt = 0; nt < 4; ++nt) { const int d = nt * 16 + fr; br_[nt] = gb[hh * 64 + d]; bi_[nt] = gb[512 + hh * 64 + d];
        const float nl = -lam[d]; sp_[nt] = (nl > 20.f) ? nl : log1pf(__expf(nl)); }
    const float w0 = convw[lane], w1 = convw[512 + lane], w2 = convw[1024 + lane], w3 = convw[1536 + lane], cb = convb[lane];
    const bf16_t* zx = z + 512 + hh * 64;
    float xm3 = (T0 >= 3) ? bf2f(zx[(size_t)(T0 - 3) * INW_ + lane]) : 0.f, xm2 = (T0 >= 2) ? bf2f(zx[(size_t)(T0 - 2) * INW_ + lane]) : 0.f, xm1 = (T0 >= 1) ? bf2f(zx[(size_t)(T0 - 1) * INW_ + lane]) : 0.f;
    float hst = 0.f, pst = 1.f;
    for (int sub = 0; sub < 8; ++sub) {
        const int t0 = T0 + sub * 16, t = t0 + fr;
        bf16x8 xf[2];
#pragma unroll
        for (int kk = 0; kk < 2; ++kk) {
            const int c0 = kk * 32 + fq * 8;
            float a[8];
            { const f32x4 b0 = *(const f32x4*)(convb + c0), b1 = *(const f32x4*)(convb + c0 + 4); a[0] = b0[0]; a[1] = b0[1]; a[2] = b0[2]; a[3] = b0[3]; a[4] = b1[0]; a[5] = b1[1]; a[6] = b1[2]; a[7] = b1[3]; }
#pragma unroll
            for (int tap = 0; tap < 4; ++tap) { const int tj = t - 3 + tap;
                const f32x4 wa = *(const f32x4*)(convw + tap * 512 + c0), wb = *(const f32x4*)(convw + tap * 512 + c0 + 4);
                bf16x8 v = (bf16x8){0, 0, 0, 0, 0, 0, 0, 0};
                if (tj >= 0) v = *(const bf16x8*)(zx + (size_t)tj * INW_ + c0);
                a[0] += wa[0] * bf2f((unsigned short)v[0]); a[1] += wa[1] * bf2f((unsigned short)v[1]); a[2] += wa[2] * bf2f((unsigned short)v[2]); a[3] += wa[3] * bf2f((unsigned short)v[3]);
                a[4] += wb[0] * bf2f((unsigned short)v[4]); a[5] += wb[1] * bf2f((unsigned short)v[5]); a[6] += wb[2] * bf2f((unsigned short)v[6]); a[7] += wb[3] * bf2f((unsigned short)v[7]); }
            u32x4 w; w.x = cvt_pk_bf16(a[0], a[1]); w.y = cvt_pk_bf16(a[2], a[3]); w.z = cvt_pk_bf16(a[4], a[5]); w.w = cvt_pk_bf16(a[6], a[7]);
            xf[kk] = __builtin_bit_cast(bf16x8, w);
        }
#pragma unroll
        for (int nt = 0; nt < 4; ++nt) {
            f32x4 ar = (f32x4){0.f, 0.f, 0.f, 0.f}, ai = (f32x4){0.f, 0.f, 0.f, 0.f};
#pragma unroll
            for (int kk = 0; kk < 2; ++kk) {
                const bf16x8 wr = *(const bf16x8*)(gwt + (size_t)(hh * 64 + nt * 16 + fr) * 64 + kk * 32 + fq * 8);
                const bf16x8 wi = *(const bf16x8*)(gwt + (size_t)((8 + hh) * 64 + nt * 16 + fr) * 64 + kk * 32 + fq * 8);
                ar = MFMA16(xf[kk], wr, ar); ai = MFMA16(xf[kk], wi, ai);
            }
#pragma unroll
            for (int j = 0; j < 4; ++j) {
                const float rg = __builtin_amdgcn_rcpf(1.0f + __expf(-(ar[j] + br_[nt]))), ig = __builtin_amdgcn_rcpf(1.0f + __expf(-(ai[j] + bi_[nt])));
                const float la = -8.0f * rg * sp_[nt];
                const float av = __expf(la), gu = sqrtf(-expm1f(2.0f * la)) * ig;
                Al[(fq * 4 + j) * 66 + nt * 16 + fr] = av; Gl[(fq * 4 + j) * 66 + nt * 16 + fr] = gu;
            }
        }
        asm volatile("s_waitcnt lgkmcnt(0)" ::: "memory");
        float xz[16];
#pragma unroll
        for (int tt = 0; tt < 16; ++tt) xz[tt] = bf2f(zx[(size_t)(t0 + tt) * INW_ + lane]);
#pragma unroll
        for (int tt = 0; tt < 16; ++tt) {
            const float xc = cb + w0 * xm3 + w1 * xm2 + w2 * xm1 + w3 * xz[tt];
            xm3 = xm2; xm2 = xm1; xm1 = xz[tt];
            const float av = Al[tt * 66 + lane], gu = Gl[tt * 66 + lane];
            hst = av * hst + gu * xc; pst = pst * av;
            HL[(size_t)(t0 + tt) * 512 + hh * 64 + lane] = hst; PC[(size_t)(t0 + tt) * 512 + hh * 64 + lane] = pst;
        }
        asm volatile("s_waitcnt lgkmcnt(0)" ::: "memory");
    }
    sumP[ck * 512 + hh * 64 + lane] = pst; sumH[ck * 512 + hh * 64 + lane] = hst;
}

__device__ __forceinline__ void mixers_phase(LAS unsigned char* lds, const Params& p, int layer) {
    const bf16_t* z = (const bf16_t*)(p.ws + OFF_HID); bf16_t* y = (bf16_t*)(p.ws + OFF_Y);
    float* HL = (float*)(p.ws + OFF_XN); float* PC = HL + (size_t)S_ * 512;
    float* sumP = (float*)(p.ws + OFF_LSUM); float* sumH = sumP + 128 * 512;
    const int tid = ltid(); const int lane = tid & 63;
    const int wid = __builtin_amdgcn_readfirstlane(tid >> 6);
    const int gwv = blockIdx.x * 8 + wid, GW = gridDim.x * 8;
    constexpr int N_LRU = 1024, N_ATT = 16384, N_POOL = 4096;
    for (int i = gwv; i < N_LRU + N_ATT + N_POOL; i += GW) {
        if (i < N_LRU) lru_item(lds + wid * 8448, z, p, layer, (const bf16_t*)(p.ws + OFF_GATEW), HL, PC, sumP, sumH, i, lane);
        else if (i < N_LRU + N_ATT) attn_item(lds + wid * 8448, z, y, i - N_LRU, lane);
        else pool_item(z, y, (const bf16_t*)(p.ws + OFF_POOLW), p.in[7] + (size_t)layer * 512, i - N_LRU - N_ATT, lane);
    }
}

__device__ __forceinline__ void lru_final_phase(const Params& p) {
    const bf16_t* z = (const bf16_t*)(p.ws + OFF_HID); bf16_t* y = (bf16_t*)(p.ws + OFF_Y);
    const float* HL = (const float*)(p.ws + OFF_XN); const float* PC = HL + (size_t)S_ * 512;
    const float* sumP = (const float*)(p.ws + OFF_LSUM); const float* sumH = sumP + 128 * 512;
    const int d = ltid();
    for (int it = blockIdx.x; it < 256; it += gridDim.x) {
        const int ck = it >> 1, t0 = it * 64;
        float carry = 0.f;
#pragma unroll 8
        for (int c = 0; c < ck; ++c) carry = sumP[c * 512 + d] * carry + sumH[c * 512 + d];
#pragma unroll 8
        for (int tt = 0; tt < 64; ++tt) { const size_t t = (size_t)(t0 + tt);
            const float hv = HL[t * 512 + d] + PC[t * 512 + d] * carry;
            const float g = bf2f(z[t * INW_ + 1024 + d]);
            const float u = 0.7978845608f * (g + 0.044715f * g * g * g);
            const float th = 1.0f - 2.0f * __builtin_amdgcn_rcpf(1.0f + __expf(2.0f * u));
            const float ge = 0.5f * g * (1.0f + th);
            y[t * D_ + 512 + d] = (bf16_t)(cvt_pk_bf16(hv * ge, 0.f) & 0xffffu); }
    }
}

__global__ void __launch_bounds__(512, 2) mk_fwd(Params p, int ph_lo, int ph_hi) {
    extern __shared__ __attribute__((aligned(16))) unsigned char shm[];
    LAS unsigned char* lds = (LAS unsigned char*)shm;
    cg::grid_group grid = cg::this_grid();
    unsigned char* ws = p.ws;
    volatile LAS unsigned* bst = (volatile LAS unsigned*)(lds + 131072);
    if (threadIdx.x < 4) bst[threadIdx.x] = 0u;
    __syncthreads();
    XcdBarrier bar = xcd_barrier_post((unsigned*)(ws + OFF_BAR), bst);
    bf16_t* XN = (bf16_t*)(ws + OFF_XN); bf16_t* HID = (bf16_t*)(ws + OFF_HID); bf16_t* H = (bf16_t*)(ws + OFF_H); bf16_t* Y = (bf16_t*)(ws + OFF_Y);
    for (int ph = ph_lo; ph < ph_hi; ++ph) {
#ifdef DUP_MASK
      for (int rep = 0; rep < ((ph > 0 && ((DUP_MASK >> ((ph - 1) % 11)) & 1)) ? 2 : 1); ++rep)
#endif
        if (ph == 0) {
            convert_phase(lds, p, 0);
            norm_phase(nullptr, p.in[0], nullptr, 0.f, nullptr, p.in[1], XN);
        } else {
            const int layer = (ph - 1) / 11, st = (ph - 1) % 11;
            const float* g = p.in[1] + (size_t)layer * 6 * D_;
            if (st == 0 || st == 8) {
                pg8::Gemm gm; gm.A = XN; gm.Bt = (const bf16_t*)(ws + (st == 0 ? OFF_W1IN : OFF_W2IN)); gm.M = S_; gm.N = 2 * DFF_; gm.K = D_;
                pg8::StaticOrder so; so.init(gm.M, gm.N, (int)gridDim.x, (int)blockIdx.x);
                pg8::EpiSwiGLU e; e.O = HID; e.ldc = DFF_;
                #ifndef NO_G1
                pg8::gemm_phase<pg8::EpiSwiGLU, pg8::StaticOrder, true, true>(lds, gm, so, e);
#endif
            } else if (st == 1 || st == 9 || st == 6 || st == 3) {
                pg8::Gemm gm; gm.M = S_; pg8::EpiBf16P e;
                if (st == 3) { gm.A = XN; gm.Bt = (const bf16_t*)(ws + OFF_WMIN); gm.N = INW_; gm.K = D_; e.O = HID; e.ldc = INW_; }
                else if (st == 6) { gm.A = Y; gm.Bt = (const bf16_t*)(ws + OFF_WMOUT); gm.N = D_; gm.K = D_; e.O = H; e.ldc = D_; }
                else { gm.A = HID; gm.Bt = (const bf16_t*)(ws + (st == 1 ? OFF_W1OUT : OFF_W2OUT)); gm.N = D_; gm.K = DFF_; e.O = H; e.ldc = D_; }
                pg8::StaticOrder so; so.init(gm.M, gm.N, (int)gridDim.x, (int)blockIdx.x);
                pg8::gemm_phase<pg8::EpiBf16P, pg8::StaticOrder, true, true>(lds, gm, so, e);
            } else if (st == 2) {
                norm_phase(H, layer == 0 ? p.in[0] : p.out, p.out, 0.5f, g + 1 * D_, g + 2 * D_, XN);
            } else if (st == 7) {
                norm_phase(H, p.out, p.out, 1.0f, g + 3 * D_, g + 4 * D_, XN);
            } else if (st == 10) {
                const bool more = (layer + 1 < DEPTH_);
                norm_phase(H, p.out, p.out, 0.5f, g + 5 * D_, more ? g + 6 * D_ : nullptr, more ? XN : nullptr);
                if (more) convert_phase(lds, p, layer + 1);
            } else if (st == 4) {
#ifndef NO_MIX
                mixers_phase(lds, p, layer);
#endif
            } else {
                lru_final_phase(p);
            }
        }
        if (ph + 1 < ph_hi) { if (ph == ph_lo) grid.sync(); else xcd_barrier(bar); }
    }
}

#ifndef MK_COOP
#define MK_COOP 1
#endif
extern "C" void kernel_launch(void* const* d_in, const int* in_sizes, int n_in, void* d_out, int out_size, void* d_ws, size_t ws_size, hipStream_t stream) {
    static int grid_blocks = 0;
    if (!grid_blocks) {
        if (n_in != 15 || out_size != S_ * D_ || ws_size < WS_END) { fprintf(stderr, "kernel_launch: unexpected shapes (n_in %d out %d ws %zu need %zu)\n", n_in, out_size, ws_size, (size_t)WS_END); grid_blocks = -1; return; }
        int dev = 0, cus = 0, per_cu = 0;
        hipGetDevice(&dev);
        hipDeviceGetAttribute(&cus, hipDeviceAttributeMultiprocessorCount, dev);
        if (hipFuncSetAttribute((const void*)mk_fwd, hipFuncAttributeMaxDynamicSharedMemorySize, LDS_BYTES) != hipSuccess) { fprintf(stderr, "kernel_launch: hipFuncSetAttribute failed\n"); grid_blocks = -1; return; }
        hipOccupancyMaxActiveBlocksPerMultiprocessor(&per_cu, (const void*)mk_fwd, 512, LDS_BYTES);
        if (per_cu < 1) { fprintf(stderr, "kernel_launch: occupancy query says %d\n", per_cu); per_cu = 1; }
        (void)hipGetLastError();
        grid_blocks = cus * per_cu;
    }
    if (grid_blocks < 0) return;
    (void)hipMemsetAsync((unsigned char*)d_ws + OFF_BAR, 0, 16384, stream);
    Params p{};
    for (int i = 0; i < 15; ++i) p.in[i] = (const float*)d_in[i];
    p.out = (float*)d_out; p.ws = (unsigned char*)d_ws;
#if MK_COOP
    int lo = 0, hi = NPHASE;
    void* args[] = {&p, &lo, &hi};
    hipError_t e = hipLaunchCooperativeKernel((const void*)mk_fwd, dim3(grid_blocks), dim3(512), args, LDS_BYTES, stream);
    if (e != hipSuccess) fprintf(stderr, "cooperative launch failed: %s (grid %d)\n", hipGetErrorString(e), grid_blocks);
#else
    for (int ph = 0; ph < NPHASE; ++ph) hipLaunchKernelGGL(mk_fwd, dim3(grid_blocks), dim3(512), LDS_BYTES, stream, p, ph, ph + 1);
#endif
}
```

```cpp
#include <hip/hip_runtime.h>
#include <hip/hip_cooperative_groups.h>
#include <cstdio>
namespace cg = cooperative_groups;
#define XB_TMO      128
#define XB_XCNT(j)  (256  + 64 * (j))
#define XB_XSUB(j)  (1280 + 64 * (j))
#define XB_XGEN(j)  (2304 + 64 * (j))
#define XB_TOP      3328
#define XB_TOPGEN   3392
#define XCD_BAR_WORDS 3456
#define XB_SPIN_CAP (1u << 18)
#define LAS __attribute__((address_space(3)))

__device__ __forceinline__ unsigned xb_ld(unsigned* p)              { return __hip_atomic_load(p, __ATOMIC_RELAXED, __HIP_MEMORY_SCOPE_AGENT); }
__device__ __forceinline__ unsigned xb_add(unsigned* p, unsigned v) { return __hip_atomic_fetch_add(p, v, __ATOMIC_RELAXED, __HIP_MEMORY_SCOPE_AGENT); }
__device__ __forceinline__ unsigned xb_xcc_id() { return (unsigned)__builtin_amdgcn_s_getreg((3 << 11) | 20) & 0xFu; }
#define XB_SPIN(cond, bar) do { unsigned _sp = 0; while (cond) { __builtin_amdgcn_s_sleep(1); \
    if ((++_sp & 255u) == 0u) { if (xb_ld(&(bar)[XB_TMO])) break; if (_sp > XB_SPIN_CAP) { atomicAdd(&(bar)[XB_TMO], 1u); break; } } } } while (0)

struct XcdBarrier {
    unsigned* bar; unsigned x;
    volatile LAS unsigned* st;
};

__device__ __forceinline__ XcdBarrier xcd_barrier_post(unsigned* bar, volatile LAS unsigned* st) {
    XcdBarrier b; b.bar = bar; b.x = xb_xcc_id(); b.st = st;
    if (threadIdx.x == 0) (void)xb_add(&bar[XB_XCNT(b.x)], 1u);
    return b;
}
__device__ __forceinline__ void xcd_barrier_complete(unsigned* bar, unsigned x, unsigned& nloc, unsigned& nx) {
    const unsigned G = gridDim.x * gridDim.y * gridDim.z;
    unsigned sum, cnt, mine, sp = 0u;
    for (;;) {
        sum = 0u; cnt = 0u; mine = 0u;
#pragma unroll
        for (unsigned j = 0; j < 16; ++j) { const unsigned c = xb_ld(&bar[XB_XCNT(j)]); sum += c; cnt += (c > 0u) ? 1u : 0u; mine = (j == x) ? c : mine; }
        if (sum == G) break;
        __builtin_amdgcn_s_sleep(1);
        if ((++sp & 255u) == 0u) { if (xb_ld(&bar[XB_TMO])) break; if (sp > XB_SPIN_CAP) { atomicAdd(&bar[XB_TMO], 1u); break; } }
    }
    nloc = mine > 0u ? mine : 1u; nx = cnt > 0u ? cnt : 1u;
}

__device__ __forceinline__ void xcd_barrier(const XcdBarrier& b) {
    asm volatile("s_waitcnt vmcnt(0)" ::: "memory");
    __syncthreads();
    if (threadIdx.x == 0) {
        unsigned* bar = b.bar;
        __builtin_amdgcn_s_waitcnt(0);
        unsigned nloc = b.st[0], nx = b.st[1];
        if (nloc == 0u) { xcd_barrier_complete(bar, b.x, nloc, nx); b.st[0] = nloc; b.st[1] = nx; }
        const unsigned old = xb_add(&bar[XB_XSUB(b.x)], 1u);
        const unsigned gen = old / nloc;
        if (old + 1u == (gen + 1u) * nloc) {
            __builtin_amdgcn_fence(__ATOMIC_RELEASE, "agent");
            asm volatile("s_waitcnt vmcnt(0)" ::: "memory");
            const unsigned og = xb_add(&bar[XB_TOP], 1u);
            const unsigned tg = og / nx;
            if (og + 1u == (tg + 1u) * nx) xb_add(&bar[XB_TOPGEN], 1u);
            else XB_SPIN(xb_ld(&bar[XB_TOPGEN]) == tg, bar);
            __builtin_amdgcn_fence(__ATOMIC_ACQUIRE, "agent");
            xb_add(&bar[XB_XGEN(b.x)], 1u);
            asm volatile("s_waitcnt vmcnt(0)" ::: "memory");
        } else {
            XB_SPIN(xb_ld(&bar[XB_XGEN(b.x)]) == gen, bar);
            __builtin_amdgcn_fence(__ATOMIC_ACQUIRE, "agent");
            asm volatile("s_waitcnt vmcnt(0)" ::: "memory");
        }
    }
    __syncthreads();
}
#include <hip/hip_runtime.h>
namespace pg8 {
#define PG8_LAS __attribute__((address_space(3)))
typedef unsigned short bf16_t;
typedef short bf16x8 __attribute__((ext_vector_type(8)));
typedef float f32x4 __attribute__((ext_vector_type(4)));
typedef unsigned u32x4 __attribute__((ext_vector_type(4)));
constexpr int BM = 256, BK = 64, HALF = 128, HTB = HALF * BK * 2  , STAGE_BYTES = 8 * HTB, NXCD = 8, WGM = 8;

__host__ __device__ __forceinline__ int lds_byte(int r, int c) { const int st = (r >> 4) * 2 + (c >> 5), rr = r & 15, cc = c & 31, ob = rr * 64 + cc * 2; return st * 1024 + (ob ^ (((ob >> 9) & 1) << 5)); }
__host__ __device__ __forceinline__ void stage_rc(int b, int& R, int& C) { const int st = b / 1024, sb = b % 1024, swz = sb ^ (((sb >> 9) & 1) << 5); R = (st >> 1) * 16 + swz / 64; C = (st & 1) * 32 + (swz % 64) / 2; }
__host__ __device__ __forceinline__ int perm32(int rho) { const int n = rho >> 4, i = rho & 15; return 8 * (i >> 2) + 4 * n + (i & 3); }

struct Unit { int pm, pn; };
struct Gemm { const bf16_t* A; const bf16_t* Bt; int M, N, K; };

struct StaticOrder {
    int nM, nN, nwg, G, c;
    __host__ __device__ void init(int M, int N, int G_, int c_) { nM = M / BM; nN = N / BM; nwg = nM * nN; G = G_; c = c_; }
    __host__ __device__ bool next(int i, Unit& u) const {
        const long L = (long)i * G + c; if (L >= nwg) return false;
        int wgid = (int)L; { const int q = nwg / NXCD, r = nwg % NXCD, xcd = wgid % NXCD, off = wgid / NXCD; wgid = (xcd < r ? xcd * (q + 1) : r * (q + 1) + (xcd - r) * q) + off; }
        const int nig = WGM * nN, gid = wgid / nig, fm = gid * WGM, gsz = (nM - fm) < WGM ? (nM - fm) : WGM;
        u.pm = fm + ((wgid % nig) % gsz); u.pn = (wgid % nig) / gsz; return true;
    }
    __device__ __forceinline__ void a_ready(const Unit&) const {}
    __device__ __forceinline__ void done(const Unit&) const {}
};
__device__ __forceinline__ unsigned cvt_pk_bf16(float lo, float hi) { unsigned r; asm volatile("v_cvt_pk_bf16_f32 %0, %1, %2" : "=v"(r) : "v"(lo), "v"(hi)); return r; }
struct EpiF32 {
    static constexpr bool PERM = false, AFTER_DRAIN = false;
    float* C; int ldc; const float* bias;
    __device__ __forceinline__ void operator()(const f32x4 (&acc)[2][2][4][2], const Unit& u, int wr, int wc, int fr, int fq) const {
        const int row0 = u.pm * BM + wr * 64 + fr, col0 = u.pn * BM + wc * 32 + 4 * fq;
        f32x4 bv[2][2];
#pragma unroll
        for (int bj = 0; bj < 2; ++bj)
#pragma unroll
            for (int n = 0; n < 2; ++n) bv[bj][n] = bias ? *(const f32x4*)(bias + col0 + bj * HALF + n * 16) : (f32x4){0.f, 0.f, 0.f, 0.f};
#pragma unroll
        for (int ai = 0; ai < 2; ++ai)
#pragma unroll
            for (int m = 0; m < 4; ++m) { float* rowp = C + (size_t)(row0 + ai * HALF + m * 16) * ldc + col0;
#pragma unroll
                for (int bj = 0; bj < 2; ++bj)
#pragma unroll
                    for (int n = 0; n < 2; ++n) *(f32x4*)(rowp + bj * HALF + n * 16) = acc[ai][bj][m][n] + bv[bj][n]; }
    }
};
typedef unsigned u32x2 __attribute__((ext_vector_type(2)));
struct EpiBf16P {
    static constexpr bool PERM = true, AFTER_DRAIN = false;
    bf16_t* O; int ldc; bf16_t* QKV;
    __device__ __forceinline__ void operator()(const f32x4 (&acc)[2][2][4][2], const Unit& u, int wr, int wc, int fr, int fq) const {
        const int row0 = u.pm * BM + wr * 64 + fr, col0 = u.pn * BM + wc * 32 + 8 * fq;
        const bool redir = (QKV != nullptr) && (u.pn >= 6);
        const int hd0 = (((u.pn - 6) >> 2) * 16 + ((u.pn - 6) & 3) * 4 + (wc >> 1));
#pragma unroll
        for (int ai = 0; ai < 2; ++ai)
#pragma unroll
            for (int m = 0; m < 4; ++m) { const int row = row0 + ai * HALF + m * 16;
                bf16_t* rowp = redir ? QKV + ((size_t)hd0 * 16384 + row) * 64 + (wc & 1) * 32 + 8 * fq : O + (size_t)row * ldc + col0;
                const size_t bjstep = redir ? (size_t)2 * 16384 * 64 : (size_t)HALF;
#pragma unroll
                for (int bj = 0; bj < 2; ++bj) { const f32x4 v0 = acc[ai][bj][m][0], v1 = acc[ai][bj][m][1];
                    u32x4 w; w.x = cvt_pk_bf16(v0[0], v0[1]); w.y = cvt_pk_bf16(v0[2], v0[3]); w.z = cvt_pk_bf16(v1[0], v1[1]); w.w = cvt_pk_bf16(v1[2], v1[3]);
                    *(u32x4*)(rowp + bj * bjstep) = w; } }
    }
};
__device__ __forceinline__ float silu_mul(float g, float u) { return g * u * __builtin_amdgcn_rcpf(1.0f + __expf(-g)); }
struct EpiSwiGLU {
    static constexpr bool PERM = true, AFTER_DRAIN = false;
    bf16_t* O; int ldc;
    __device__ __forceinline__ void operator()(const f32x4 (&acc)[2][2][4][2], const Unit& u, int wr, int wc, int fr, int fq) const {
        const int row0 = u.pm * BM + wr * 64 + fr, col0 = u.pn * HALF + wc * 32 + 8 * fq;
#pragma unroll
        for (int ai = 0; ai < 2; ++ai)
#pragma unroll
            for (int m = 0; m < 4; ++m) { bf16_t* rowp = O + (size_t)(row0 + ai * HALF + m * 16) * ldc + col0;
                const f32x4 g0 = acc[ai][0][m][0], g1 = acc[ai][0][m][1], u0 = acc[ai][1][m][0], u1 = acc[ai][1][m][1];
                u32x4 w; w.x = cvt_pk_bf16(silu_mul(g0[0], u0[0]), silu_mul(g0[1], u0[1])); w.y = cvt_pk_bf16(silu_mul(g0[2], u0[2]), silu_mul(g0[3], u0[3]));
                w.z = cvt_pk_bf16(silu_mul(g1[0], u1[0]), silu_mul(g1[1], u1[1])); w.w = cvt_pk_bf16(silu_mul(g1[2], u1[2]), silu_mul(g1[3], u1[3]));
                *(u32x4*)rowp = w; }
    }
};

template <class Epi, class Sched, bool ALIGN_EPI = false, bool SP2 = false>
__device__ __forceinline__ void gemm_phase(PG8_LAS unsigned char* lds, const Gemm g, const Sched& S, const Epi& E) {
    int tid_l = threadIdx.x; asm volatile("" : "+v"(tid_l));
    const int tid = tid_l, wid = __builtin_amdgcn_readfirstlane(tid >> 6), lane = tid & 63, wr = wid >> 2, wc = wid & 3, fr = lane & 15, fq = lane >> 4;
    const int K = g.K, nt = K / BK;
    unsigned voffA[2], voffB[2];
#pragma unroll
    for (int i = 0; i < 2; ++i) { int R, C; stage_rc(tid * 16 + i * 8192, R, C); const int Rb = Epi::PERM ? ((R & ~31) + perm32(R & 31)) : R;
        voffA[i] = (unsigned)(R * K + C) * 2u; voffB[i] = (unsigned)(Rb * K + C) * 2u; }
    const size_t kstep = (size_t)(BK * 2);
    const size_t hstep = (size_t)HALF * K * 2;
    const size_t tstep = 2 * hstep;
    const unsigned ldsw = (unsigned)wid * 1024u;
    const int aoff = lds_byte(wr * 64 + fr, fq * 8), boff = lds_byte(wc * 32 + fr, fq * 8);
#define PG8_SA(b, h) (((b) * 2 + (h)) * HTB)
#define PG8_SB(b, h) ((4 + (b) * 2 + (h)) * HTB)
#define PG8_STAGE(bufoff, gbase, voff) do { _Pragma("unroll") for (int _i = 0; _i < 2; ++_i) \
        __builtin_amdgcn_global_load_lds((const unsigned*)((const char*)(gbase) + (voff)[_i]), (PG8_LAS unsigned*)(lds + (bufoff) + ldsw + _i * 8192), 16, 0, 0); } while (0)
#define PG8_LDA(dst, b, h) do { _Pragma("unroll") for (int m = 0; m < 4; ++m) _Pragma("unroll") for (int k = 0; k < 2; ++k) dst[m][k] = *(const PG8_LAS bf16x8*)(lds + PG8_SA(b, h) + aoff + m * 2048 + k * 1024); } while (0)
#define PG8_LDB(dst, b, h) do { _Pragma("unroll") for (int n = 0; n < 2; ++n) _Pragma("unroll") for (int k = 0; k < 2; ++k) dst[n][k] = *(const PG8_LAS bf16x8*)(lds + PG8_SB(b, h) + boff + n * 2048 + k * 1024); } while (0)
#define PG8_MMA(ai, bj, At, Bt) do { __builtin_amdgcn_s_setprio(1); _Pragma("unroll") for (int m = 0; m < 4; ++m) _Pragma("unroll") for (int n = 0; n < 2; ++n) _Pragma("unroll") for (int k = 0; k < 2; ++k) \
        acc[ai][bj][m][n] = __builtin_amdgcn_mfma_f32_16x16x32_bf16(Bt[n][k], At[m][k], acc[ai][bj][m][n], 0, 0, 0); __builtin_amdgcn_s_setprio(0); } while (0)
#define PG8_WAIT_V(n) asm volatile("s_waitcnt vmcnt(" #n ")" ::: "memory")
#define PG8_WAIT_L(n) asm volatile("s_waitcnt lgkmcnt(" #n ")" ::: "memory")
#define PG8_BAR __builtin_amdgcn_s_barrier()
#define PG8_SCHED __builtin_amdgcn_sched_barrier(0)
    Unit cur, nxt; int ui = 0;
    if (!S.next(0, cur)) return;
    f32x4 acc[2][2][4][2];
#pragma unroll
    for (int a = 0; a < 2; ++a)
#pragma unroll
        for (int b = 0; b < 2; ++b)
#pragma unroll
            for (int m = 0; m < 4; ++m)
#pragma unroll
                for (int n = 0; n < 2; ++n) acc[a][b][m][n] = (f32x4){0.f, 0.f, 0.f, 0.f};
    bf16x8 At[4][2], B0[2][2], B1[2][2];
    const char* cA = (const char*)g.A + (size_t)cur.pm * tstep; const char* cB = (const char*)g.Bt + (size_t)cur.pn * tstep;
    S.a_ready(cur);
    if constexpr (SP2) {
        PG8_STAGE(PG8_SB(0, 0), cB, voffB); PG8_STAGE(PG8_SB(0, 1), cB + hstep, voffB); PG8_STAGE(PG8_SA(0, 0), cA, voffA); PG8_STAGE(PG8_SA(0, 1), cA + hstep, voffA);
        if (wr == 1) PG8_BAR;
        PG8_WAIT_V(2); PG8_BAR;
        PG8_STAGE(PG8_SB(1, 0), cB + kstep, voffB); PG8_STAGE(PG8_SA(1, 0), cA + kstep, voffA); PG8_STAGE(PG8_SB(1, 1), cB + hstep + kstep, voffB);
        PG8_WAIT_V(6); PG8_BAR;
    } else {
        PG8_STAGE(PG8_SB(0, 0), cB, voffB); PG8_STAGE(PG8_SA(0, 0), cA, voffA); PG8_STAGE(PG8_SB(0, 1), cB + hstep, voffB); PG8_STAGE(PG8_SA(0, 1), cA + hstep, voffA);
        if (wr == 1) PG8_BAR;
        PG8_WAIT_V(4); PG8_BAR;
        PG8_STAGE(PG8_SB(1, 0), cB + kstep, voffB); PG8_STAGE(PG8_SA(1, 0), cA + kstep, voffA); PG8_STAGE(PG8_SB(1, 1), cB + hstep + kstep, voffB);
        PG8_WAIT_V(6); PG8_BAR;
    }
    for (;;) {
        const bool has_next = S.next(ui + 1, nxt);
        const char* nA = has_next ? (const char*)g.A + (size_t)nxt.pm * tstep : cA; const char* nB = has_next ? (const char*)g.Bt + (size_t)nxt.pn * tstep : cB;
        for (int t = 0; t < nt; t += 2) {
            const bool last = (t == nt - 2);
            const char* a1 = cA + (size_t)(t + 1) * kstep;
            const char* a2 = last ? nA : cA + (size_t)(t + 2) * kstep; const char* b2 = last ? nB : cB + (size_t)(t + 2) * kstep;
            const char* a3 = a2 + kstep; const char* b3 = b2 + kstep;
            if (last && has_next) S.a_ready(nxt);
            if constexpr (SP2) {
            PG8_LDB(B0, 0, 0); PG8_LDB(B1, 0, 1); PG8_SCHED; PG8_LDA(At, 0, 0); PG8_STAGE(PG8_SA(1, 1), a1 + hstep, voffA);
            PG8_WAIT_V(8); PG8_WAIT_L(0); PG8_BAR; PG8_MMA(0, 0, At, B0); PG8_MMA(0, 1, At, B1); PG8_BAR; PG8_SCHED;
            PG8_LDA(At, 0, 1); PG8_STAGE(PG8_SB(0, 0), b2, voffB); PG8_STAGE(PG8_SB(0, 1), b2 + hstep, voffB); PG8_STAGE(PG8_SA(0, 0), a2, voffA);
            PG8_WAIT_V(8); PG8_WAIT_L(0); PG8_BAR; PG8_MMA(1, 0, At, B0); PG8_MMA(1, 1, At, B1); PG8_BAR; PG8_SCHED;
            PG8_LDB(B0, 1, 0); PG8_LDB(B1, 1, 1); PG8_SCHED; PG8_LDA(At, 1, 0); PG8_STAGE(PG8_SA(0, 1), a2 + hstep, voffA);
            PG8_WAIT_V(8); PG8_WAIT_L(0); PG8_BAR; PG8_MMA(0, 0, At, B0); PG8_MMA(0, 1, At, B1); PG8_BAR; PG8_SCHED;
            PG8_LDA(At, 1, 1); PG8_STAGE(PG8_SB(1, 0), b3, voffB); PG8_STAGE(PG8_SB(1, 1), b3 + hstep, voffB); PG8_STAGE(PG8_SA(1, 0), a3, voffA);
            PG8_WAIT_V(8); PG8_WAIT_L(0); PG8_BAR; PG8_MMA(1, 0, At, B0); PG8_MMA(1, 1, At, B1); PG8_BAR; PG8_SCHED;
            } else {
            PG8_LDB(B0, 0, 0); PG8_SCHED; PG8_LDA(At, 0, 0); PG8_STAGE(PG8_SA(1, 1), a1 + hstep, voffA);
            PG8_WAIT_L(8); PG8_BAR; PG8_WAIT_L(0); PG8_MMA(0, 0, At, B0); PG8_BAR; PG8_SCHED;
            PG8_LDB(B1, 0, 1); PG8_STAGE(PG8_SB(0, 0), b2, voffB);
            PG8_BAR; PG8_WAIT_L(0); PG8_MMA(0, 1, At, B1); PG8_BAR;
            PG8_LDA(At, 0, 1); PG8_STAGE(PG8_SA(0, 0), a2, voffA);
            PG8_BAR; PG8_WAIT_L(0); PG8_MMA(1, 0, At, B0); PG8_BAR; PG8_SCHED;
            PG8_STAGE(PG8_SB(0, 1), b2 + hstep, voffB);
            PG8_WAIT_V(6); PG8_BAR; PG8_MMA(1, 1, At, B1); PG8_BAR;
            PG8_LDB(B0, 1, 0); PG8_SCHED; PG8_LDA(At, 1, 0); PG8_STAGE(PG8_SA(0, 1), a2 + hstep, voffA);
            PG8_WAIT_L(8); PG8_BAR; PG8_WAIT_L(0); PG8_MMA(0, 0, At, B0); PG8_BAR; PG8_SCHED;
            PG8_LDB(B1, 1, 1); PG8_STAGE(PG8_SB(1, 0), b3, voffB);
            PG8_BAR; PG8_WAIT_L(0); PG8_MMA(0, 1, At, B1); PG8_BAR;
            PG8_LDA(At, 1, 1); PG8_STAGE(PG8_SA(1, 0), a3, voffA);
            PG8_BAR; PG8_WAIT_L(0); PG8_MMA(1, 0, At, B0); PG8_BAR; PG8_SCHED;
            PG8_STAGE(PG8_SB(1, 1), b3 + hstep, voffB);
            PG8_WAIT_V(6); PG8_BAR; PG8_MMA(1, 1, At, B1); PG8_BAR;
            }
        }
        if constexpr (ALIGN_EPI) { if (wr == 0) PG8_BAR; }
        if constexpr (!Epi::AFTER_DRAIN) { E(acc, cur, wr, wc, fr, fq); S.done(cur); }
        if (!has_next) break;
#pragma unroll
        for (int a = 0; a < 2; ++a)
#pragma unroll
            for (int b = 0; b < 2; ++b)
#pragma unroll
                for (int m = 0; m < 4; ++m)
#pragma unroll
                    for (int n = 0; n < 2; ++n) acc[a][b][m][n] = (f32x4){0.f, 0.f, 0.f, 0.f};
        cur = nxt; cA = nA; cB = nB; ++ui;
        if constexpr (ALIGN_EPI) { if (wr == 1) PG8_BAR; }
    }
    PG8_WAIT_V(0);
    if constexpr (!ALIGN_EPI) { if (wr == 0) PG8_BAR; }
    PG8_BAR;
    if constexpr (Epi::AFTER_DRAIN) { E.fused(acc, cur, wr, wc, fr, fq, lds, wid, lane); S.done(cur); }
#undef PG8_SA
#undef PG8_SB
#undef PG8_STAGE
#undef PG8_LDA
#undef PG8_LDB
#undef PG8_MMA
#undef PG8_WAIT_V
#undef PG8_WAIT_L
#undef PG8_BAR
#undef PG8_SCHED
}
}

using pg8::bf16_t; using pg8::bf16x8; using pg8::f32x4; using pg8::u32x4; using pg8::u32x2; using pg8::cvt_pk_bf16;

constexpr int S_ = 16384, D_ = 2048, DFF_ = 5632, INW_ = 4608, DEPTH_ = 2;
constexpr int LDS_BYTES = 131072 + 16;
constexpr size_t SZ_WIN = (size_t)2 * DFF_ * D_ * 2, SZ_WOUT = (size_t)D_ * DFF_ * 2, SZ_WMIN = (size_t)INW_ * D_ * 2, SZ_WMOUT = (size_t)D_ * D_ * 2;
constexpr size_t OFF_W1IN = 0, OFF_W1OUT = OFF_W1IN + SZ_WIN, OFF_WMIN = OFF_W1OUT + SZ_WOUT, OFF_WMOUT = OFF_WMIN + SZ_WMIN, OFF_W2IN = OFF_WMOUT + SZ_WMOUT, OFF_W2OUT = OFF_W2IN + SZ_WIN;
constexpr size_t OFF_POOLW = OFF_W2OUT + SZ_WOUT, OFF_GATEW = OFF_POOLW + 131072, OFF_LSUM = OFF_GATEW + 131072;
constexpr size_t OFF_XN = OFF_LSUM + 524288, OFF_HID = OFF_XN + (size_t)S_ * D_ * 2, OFF_H = OFF_HID + (size_t)S_ * DFF_ * 2, OFF_Y = OFF_H + (size_t)S_ * D_ * 2, OFF_BAR = OFF_Y + (size_t)S_ * D_ * 2, OFF_QKV = OFF_BAR + 16384, WS_END = OFF_QKV + (size_t)3 * 16 * S_ * 64 * 2;
constexpr int NPHASE = 1 + 11 * DEPTH_;

struct Params { const float* in[15]; float* out; unsigned char* ws; };

__device__ __forceinline__ int ltid() { int t = threadIdx.x; asm volatile("" : "+v"(t)); return t; }
__device__ __forceinline__ float bf2f(unsigned short b) { return __uint_as_float(((unsigned)b) << 16); }
__device__ __forceinline__ float wave_sum(float v) {
#pragma unroll
    for (int o = 32; o > 0; o >>= 1) v += __shfl_xor(v, o);
    return v;
}

__device__ __forceinline__ void convert_tile(LAS unsigned char* lds, const float* __restrict__ src, bf16_t* __restrict__ dst, int K, int srcN, int perm, int nt_idx, int kt_idx, int tid) {
    const int n = tid & 63, kg = tid >> 6;
    const int np0 = nt_idx * 64;
    int sc0 = np0;
    if (perm) { const int pn = np0 >> 8, bj = (np0 >> 7) & 1, j = np0 & 127; sc0 = bj * DFF_ + pn * 128 + j; }
    const float* s = src + (size_t)(kt_idx * 128 + kg * 16) * srcN + sc0 + n;
    float v[16];
#pragma unroll
    for (int i = 0; i < 16; ++i) v[i] = __builtin_nontemporal_load(s + (size_t)i * srcN);
#pragma unroll
    for (int i = 0; i < 4; ++i) { u32x2 w; w.x = cvt_pk_bf16(v[i * 4], v[i * 4 + 1]); w.y = cvt_pk_bf16(v[i * 4 + 2], v[i * 4 + 3]);
        *(LAS u32x2*)(lds + n * 264 + (kg * 4 + i) * 8) = w; }
    __syncthreads();
#pragma unroll
    for (int pass = 0; pass < 2; ++pass) { const int row = pass * 32 + (tid >> 4), c = tid & 15;
        const u32x2 a = *(const LAS u32x2*)(lds + row * 264 + c * 16), b = *(const LAS u32x2*)(lds + row * 264 + c * 16 + 8);
        u32x4 o; o.x = a.x; o.y = a.y; o.z = b.x; o.w = b.y;
        *(u32x4*)(dst + (size_t)(np0 + row) * K + kt_idx * 128 + c * 8) = o; }
    __syncthreads();
}

__device__ __forceinline__ void convert_phase(LAS unsigned char* lds, const Params& p, int layer) {
    unsigned char* ws = p.ws; const int tid = ltid();
    const int ntiles[6] = {2816, 1408, 1152, 512, 2816, 1408};
    int total = 0;
#pragma unroll
    for (int j = 0; j < 6; ++j) total += ntiles[j];
    for (int T = blockIdx.x; T < total; T += gridDim.x) {
        int loc = T; int job = 0;
#pragma unroll
        for (int j = 0; j < 5; ++j) if (job == j && loc >= ntiles[j]) { loc -= ntiles[j]; job = j + 1; }
        const float* src; bf16_t* dst; int K, srcN, perm, ntn;
        switch (job) {
            case 0: src = p.in[2] + (size_t)layer * D_ * 2 * DFF_; dst = (bf16_t*)(ws + OFF_W1IN); K = D_; srcN = 2 * DFF_; perm = 1; ntn = 2 * DFF_ / 64; break;
            case 1: src = p.in[3] + (size_t)layer * DFF_ * D_; dst = (bf16_t*)(ws + OFF_W1OUT); K = DFF_; srcN = D_; perm = 0; ntn = D_ / 64; break;
            case 2: src = p.in[4] + (size_t)layer * D_ * INW_; dst = (bf16_t*)(ws + OFF_WMIN); K = D_; srcN = INW_; perm = 0; ntn = INW_ / 64; break;
            case 3: src = p.in[5] + (size_t)layer * D_ * D_; dst = (bf16_t*)(ws + OFF_WMOUT); K = D_; srcN = D_; perm = 0; ntn = D_ / 64; break;
            case 4: src = p.in[13] + (size_t)layer * D_ * 2 * DFF_; dst = (bf16_t*)(ws + OFF_W2IN); K = D_; srcN = 2 * DFF_; perm = 1; ntn = 2 * DFF_ / 64; break;
            default: src = p.in[14] + (size_t)layer * DFF_ * D_; dst = (bf16_t*)(ws + OFF_W2OUT); K = DFF_; srcN = D_; perm = 0; ntn = D_ / 64; break;
        }
        const int kt = loc / ntn, nt = loc - kt * ntn;
        convert_tile(lds, src, dst, K, srcN, perm, nt, kt, tid);
    }
    const float* pw = p.in[6] + (size_t)layer * 65536; const float* gw = p.in[10] + (size_t)layer * 65536;
    bf16_t* pwt = (bf16_t*)(ws + OFF_POOLW); bf16_t* gwt = (bf16_t*)(ws + OFF_GATEW);
    for (int i = blockIdx.x * 512 + tid; i < 131072; i += gridDim.x * 512) {
        if (i < 65536) { const int g = i >> 14, d = (i >> 7) & 127, c = i & 127; pwt[i] = (bf16_t)(cvt_pk_bf16(pw[(g * 128 + c) * 128 + d], 0.f) & 0xffffu); }
        else { const int k = i - 65536; const int gh = k >> 12, d = (k >> 6) & 63, c = k & 63; gwt[k] = (bf16_t)(cvt_pk_bf16(gw[(gh * 64 + c) * 64 + d], 0.f) & 0xffffu); }
    }
}

__device__ __forceinline__ void norm_phase(const bf16_t* __restrict__ h, const float* xs, float* xd, float coef, const float* __restrict__ ga, const float* __restrict__ gb, bf16_t* __restrict__ xn) {
    const int tid = ltid(); const int lane = tid & 63, gwv = blockIdx.x * 8 + (tid >> 6), GW = gridDim.x * 8;
    for (int row0 = gwv; row0 < S_; row0 += 2 * GW) {
        const int row1 = (row0 + GW < S_) ? row0 + GW : row0;
        f32x4 xa[8], xb[8]; u32x2 ha[8], hb[8];
        const f32x4* xr0 = (const f32x4*)(xs + (size_t)row0 * D_); const f32x4* xr1 = (const f32x4*)(xs + (size_t)row1 * D_);
#pragma unroll
        for (int i = 0; i < 8; ++i) { xa[i] = xr0[lane + i * 64]; xb[i] = xr1[lane + i * 64]; }
        if (h) {
            const u32x2* hr0 = (const u32x2*)(h + (size_t)row0 * D_); const u32x2* hr1 = (const u32x2*)(h + (size_t)row1 * D_);
#pragma unroll
            for (int i = 0; i < 8; ++i) { ha[i] = hr0[lane + i * 64]; hb[i] = hr1[lane + i * 64]; }
            float s0 = 0.f, s1 = 0.f;
#pragma unroll
            for (int i = 0; i < 8; ++i) {
                const float a0 = __uint_as_float(ha[i].x << 16), a1 = __uint_as_float(ha[i].x & 0xffff0000u), a2 = __uint_as_float(ha[i].y << 16), a3 = __uint_as_float(ha[i].y & 0xffff0000u);
                const float b0 = __uint_as_float(hb[i].x << 16), b1 = __uint_as_float(hb[i].x & 0xffff0000u), b2 = __uint_as_float(hb[i].y << 16), b3 = __uint_as_float(hb[i].y & 0xffff0000u);
                s0 += a0 * a0 + a1 * a1 + a2 * a2 + a3 * a3; s1 += b0 * b0 + b1 * b1 + b2 * b2 + b3 * b3; }
            s0 = wave_sum(s0); s1 = wave_sum(s1);
            const float r0 = coef * rsqrtf(s0 * (1.0f / D_) + 1e-6f), r1 = coef * rsqrtf(s1 * (1.0f / D_) + 1e-6f);
            f32x4* xw0 = (f32x4*)(xd + (size_t)row0 * D_); f32x4* xw1 = (f32x4*)(xd + (size_t)row1 * D_);
#pragma unroll
            for (int i = 0; i < 8; ++i) { const f32x4 g = ((const f32x4*)ga)[lane + i * 64];
                const f32x4 hva = (f32x4){__uint_as_float(ha[i].x << 16), __uint_as_float(ha[i].x & 0xffff0000u), __uint_as_float(ha[i].y << 16), __uint_as_float(ha[i].y & 0xffff0000u)};
                const f32x4 hvb = (f32x4){__uint_as_float(hb[i].x << 16), __uint_as_float(hb[i].x & 0xffff0000u), __uint_as_float(hb[i].y << 16), __uint_as_float(hb[i].y & 0xffff0000u)};
                xa[i] = xa[i] + hva * g * r0; xb[i] = xb[i] + hvb * g * r1; xw0[lane + i * 64] = xa[i]; xw1[lane + i * 64] = xb[i]; }
        }
        if (xn) {
            float s0 = 0.f, s1 = 0.f;
#pragma unroll
            for (int i = 0; i < 8; ++i) { s0 += xa[i][0] * xa[i][0] + xa[i][1] * xa[i][1] + xa[i][2] * xa[i][2] + xa[i][3] * xa[i][3]; s1 += xb[i][0] * xb[i][0] + xb[i][1] * xb[i][1] + xb[i][2] * xb[i][2] + xb[i][3] * xb[i][3]; }
            s0 = wave_sum(s0); s1 = wave_sum(s1);
            const float r0 = rsqrtf(s0 * (1.0f / D_) + 1e-6f), r1 = rsqrtf(s1 * (1.0f / D_) + 1e-6f);
            u32x2* xo0 = (u32x2*)(xn + (size_t)row0 * D_); u32x2* xo1 = (u32x2*)(xn + (size_t)row1 * D_);
#pragma unroll
            for (int i = 0; i < 8; ++i) { const f32x4 g = ((const f32x4*)gb)[lane + i * 64]; const f32x4 ya = xa[i] * g * r0, yb = xb[i] * g * r1;
                u32x2 w0, w1; w0.x = cvt_pk_bf16(ya[0], ya[1]); w0.y = cvt_pk_bf16(ya[2], ya[3]); w1.x = cvt_pk_bf16(yb[0], yb[1]); w1.y = cvt_pk_bf16(yb[2], yb[3]);
                xo0[lane + i * 64] = w0; xo1[lane + i * 64] = w1; }
        }
    }
}

#define MFMA16(a, b, c) __builtin_amdgcn_mfma_f32_16x16x32_bf16((a), (b), (c), 0, 0, 0)

typedef short s16x4 __attribute__((ext_vector_type(4)));
__device__ __forceinline__ void attn_chunk_geom(int ci, int P0, int& kb, int& sh, int& ksel) {
    if (ci < 12) { sh = 0; kb = P0 - 128 + ci * 32; ksel = -1; } else if (ci < 18) { sh = 2; kb = P0 - 512 + ((ci - 12) * 32) * 4; ksel = -1; }
    else { const int k = (ci - 18) / 5, c = (ci - 18) - 5 * k; sh = 4; kb = P0 + 4 * k - 2048 + (c * 32) * 16; ksel = k; }
}
__device__ __forceinline__ void attn_load(const bf16_t* __restrict__ zk, const bf16_t* __restrict__ zv, int kb, int sh, int fr, int lane, bf16x8 (&kq)[4], bf16x8 (&vq)[4]) {
#pragma unroll
    for (int t = 0; t < 2; ++t) { int kp = kb + ((t * 16 + fr) << sh); kp = kp < 0 ? 0 : (kp > S_ - 1 ? S_ - 1 : kp);
        const bf16_t* kr = zk + (size_t)kp * 64; kq[t * 2] = *(const bf16x8*)kr; kq[t * 2 + 1] = *(const bf16x8*)(kr + 32); }
#pragma unroll
    for (int i = 0; i < 4; ++i) { int kp = kb + ((i * 8 + (lane >> 3)) << sh); kp = kp < 0 ? 0 : (kp > S_ - 1 ? S_ - 1 : kp);
        vq[i] = *(const bf16x8*)(zv + (size_t)kp * 64); }
}
__device__ __forceinline__ void attn_tile(const bf16x8 (&kq)[4], const bf16x8 (&vf)[4], int kb, int sh, const bf16x8 qf0, const bf16x8 qf1, int pq, int fq, float slope, float& m, float& l, f32x4 (&o)[4]) {
    f32x4 st[2];
#pragma unroll
    for (int t = 0; t < 2; ++t) { st[t] = MFMA16(kq[t * 2], qf0, ((f32x4){0.f, 0.f, 0.f, 0.f})); st[t] = MFMA16(kq[t * 2 + 1], qf1, st[t]); }
    const int wmax = 128 << sh;
    float sv[8]; bool ok[8]; float cmax = -1e30f;
#pragma unroll
    for (int i = 0; i < 8; ++i) {
        const int kp = kb + (((i >> 2) * 16 + fq * 4 + (i & 3)) << sh), delta = pq - kp;
        ok[i] = (delta >= 0) && (delta <= wmax) && (kp >= 0);
        sv[i] = ok[i] ? st[i >> 2][i & 3] * 0.125f - slope * (float)delta : -1e30f;
        cmax = fmaxf(cmax, sv[i]);
    }
    cmax = fmaxf(cmax, __shfl_xor(cmax, 16)); cmax = fmaxf(cmax, __shfl_xor(cmax, 32));
    const float mn = fmaxf(m, cmax), alpha = __expf(m - mn);
    m = mn;
    float ps = 0.f; float pv[8];
#pragma unroll
    for (int i = 0; i < 8; ++i) { pv[i] = ok[i] ? __expf(sv[i] - mn) : 0.f; ps += pv[i]; }
    l = l * alpha + ps;
    u32x4 pw; pw.x = cvt_pk_bf16(pv[0], pv[1]); pw.y = cvt_pk_bf16(pv[2], pv[3]); pw.z = cvt_pk_bf16(pv[4], pv[5]); pw.w = cvt_pk_bf16(pv[6], pv[7]);
    const bf16x8 pf = __builtin_bit_cast(bf16x8, pw);
#pragma unroll
    for (int dvt = 0; dvt < 4; ++dvt) { o[dvt] = o[dvt] * alpha; o[dvt] = MFMA16(vf[dvt], pf, o[dvt]); }
}
__device__ __forceinline__ void attn_chunk4(const bf16x8 (&kq)[4], const bf16x8 (&vq)[4], int kb, int sh, int ksel, LAS unsigned char* vst, LAS unsigned char* vrd, const bf16x8 (&qf)[4][2],
                                            int pq0, int fq, float slope, float (&m)[4], float (&l)[4], f32x4 (&o)[4][4]) {
#pragma unroll
    for (int i = 0; i < 4; ++i) *(LAS bf16x8*)(vst + i * 8 * 144) = vq[i];
    bf16x8 vf[4];
#pragma unroll
    for (int dvt = 0; dvt < 4; ++dvt) {
        const s16x4 lo = __builtin_amdgcn_ds_read_tr16_b64_v4i16((LAS s16x4*)(vrd + dvt * 32));
        const s16x4 hi = __builtin_amdgcn_ds_read_tr16_b64_v4i16((LAS s16x4*)(vrd + 16 * 144 + dvt * 32));
        vf[dvt] = (bf16x8){lo[0], lo[1], lo[2], lo[3], hi[0], hi[1], hi[2], hi[3]};
    }
#pragma unroll
    for (int k = 0; k < 4; ++k) if (ksel < 0 || ksel == k) attn_tile(kq, vf, kb, sh, qf[k][0], qf[k][1], pq0 + 4 * k, fq, slope, m[k], l[k], o[k]);
}
__device__ __forceinline__ void attn_item(LAS unsigned char* vl, const bf16_t* __restrict__ z, bf16_t* __restrict__ y, int Bblk, int head, int rho, int lane) {
    const int fr = lane & 15, fq = lane >> 4;
    const int P0 = Bblk * 256 + rho, pq0 = P0 + 16 * fr;
    const float slope = exp2f(-0.5f * (float)(head + 1));
    const bf16_t* zq = z + ((size_t)head * S_ + pq0) * 64 + fq * 8;
    bf16x8 qf[4][2];
#pragma unroll
    for (int k = 0; k < 4; ++k) { qf[k][0] = *(const bf16x8*)(zq + k * 4 * 64); qf[k][1] = *(const bf16x8*)(zq + k * 4 * 64 + 32); }
    const bf16_t* zk = z + (size_t)(16 + head) * S_ * 64 + fq * 8;
    const bf16_t* zv = z + (size_t)(32 + head) * S_ * 64 + (lane & 7) * 8;
    LAS unsigned char* vst = vl + (lane >> 3) * 144 + (lane & 7) * 16;
    LAS unsigned char* vrd = vl + (fq * 4 + (fr >> 2)) * 144 + (fr & 3) * 8;
    float m[4], l[4]; f32x4 o[4][4];
#pragma unroll
    for (int k = 0; k < 4; ++k) { m[k] = -1e30f; l[k] = 0.f;
#pragma unroll
        for (int i = 0; i < 4; ++i) o[k][i] = (f32x4){0.f, 0.f, 0.f, 0.f}; }
    bf16x8 k0[4], v0[4], k1[4], v1[4];
    int kb, sh, ks, kbn, shn, ksn;
    attn_chunk_geom(0, P0, kb, sh, ks); attn_load(zk, zv, kb, sh, fr, lane, k0, v0);
#pragma unroll 1
    for (int ci = 0; ci < 38; ci += 2) {
        attn_chunk_geom(ci + 1, P0, kbn, shn, ksn); attn_load(zk, zv, kbn, shn, fr, lane, k1, v1);
        attn_chunk_geom(ci, P0, kb, sh, ks); attn_chunk4(k0, v0, kb, sh, ks, vst, vrd, qf, pq0, fq, slope, m, l, o);
        attn_chunk_geom(ci + 2 < 38 ? ci + 2 : 37, P0, kbn, shn, ksn); attn_load(zk, zv, kbn, shn, fr, lane, k0, v0);
        attn_chunk_geom(ci + 1, P0, kb, sh, ks); attn_chunk4(k1, v1, kb, sh, ks, vst, vrd, qf, pq0, fq, slope, m, l, o);
    }
#pragma unroll
    for (int k = 0; k < 4; ++k) {
        float lk = l[k]; lk += __shfl_xor(lk, 16); lk += __shfl_xor(lk, 32);
        const float inv = 1.0f / lk;
        bf16_t* yo = y + (size_t)(pq0 + 4 * k) * D_ + 1024 + head * 64 + fq * 4;
#pragma unroll
        for (int dvt = 0; dvt < 4; ++dvt) { u32x2 w; w.x = cvt_pk_bf16(o[k][dvt][0] * inv, o[k][dvt][1] * inv); w.y = cvt_pk_bf16(o[k][dvt][2] * inv, o[k][dvt][3] * inv); *(u32x2*)(yo + dvt * 16) = w; }
    }
}

template <int WIN> __device__ __forceinline__ void pool_item(const bf16_t* __restrict__ z, bf16_t* __restrict__ y, const bf16_t* __restrict__ pwt, const float* __restrict__ scale, int item, int lane) {
    const int fr = lane & 15, fq = lane >> 4;
    constexpr int win = WIN, gi = (WIN == 2) ? 0 : (WIN == 4) ? 1 : (WIN == 8) ? 2 : 3; const int t = item * 16 + fr;
    const float invn = 1.0f / (float)((t + 1) < win ? (t + 1) : win);
    const bf16_t* wb = pwt + (size_t)gi * 16384 + fr * 128 + fq * 8;
    f32x4 acc[8];
#pragma unroll
    for (int dt = 0; dt < 8; ++dt) acc[dt] = (f32x4){0.f, 0.f, 0.f, 0.f};
#pragma unroll 1
    for (int kk = 0; kk < 4; ++kk) {
        const bf16_t* zc = z + gi * 128 + kk * 32 + fq * 8;
        float s[8];
#pragma unroll
        for (int e = 0; e < 8; ++e) s[e] = 0.f;
        const bf16x8 self = *(const bf16x8*)(zc + (size_t)t * INW_);
#pragma unroll
        for (int j = 0; j < win; ++j) { const int tj = t - j; const bf16x8 v = *(const bf16x8*)(zc + (size_t)(tj < 0 ? 0 : tj) * INW_); const float f = (tj >= 0) ? 1.0f : 0.0f;
#pragma unroll
            for (int e = 0; e < 8; ++e) s[e] += f * bf2f((unsigned short)v[e]); }
        u32x4 w;
        w.x = cvt_pk_bf16(s[0] * invn - bf2f((unsigned short)self[0]), s[1] * invn - bf2f((unsigned short)self[1]));
        w.y = cvt_pk_bf16(s[2] * invn - bf2f((unsigned short)self[2]), s[3] * invn - bf2f((unsigned short)self[3]));
        w.z = cvt_pk_bf16(s[4] * invn - bf2f((unsigned short)self[4]), s[5] * invn - bf2f((unsigned short)self[5]));
        w.w = cvt_pk_bf16(s[6] * invn - bf2f((unsigned short)self[6]), s[7] * invn - bf2f((unsigned short)self[7]));
        const bf16x8 pf = __builtin_bit_cast(bf16x8, w);
#pragma unroll
        for (int dt = 0; dt < 8; ++dt) { const bf16x8 wf = *(const bf16x8*)(wb + dt * 16 * 128 + kk * 32); acc[dt] = MFMA16(wf, pf, acc[dt]); }
    }
    bf16_t* yo = y + (size_t)t * D_ + gi * 128 + fq * 4;
    const float* sc = scale + gi * 128 + fq * 4;
#pragma unroll
    for (int dt = 0; dt < 8; ++dt) {
        const f32x4 s4 = *(const f32x4*)(sc + dt * 16);
        u32x2 w; w.x = cvt_pk_bf16(acc[dt][0] * s4[0], acc[dt][1] * s4[1]); w.y = cvt_pk_bf16(acc[dt][2] * s4[2], acc[dt][3] * s4[3]);
        *(u32x2*)(yo + dt * 16) = w;
    }
}

__device__ __forceinline__ void lru_item(LAS unsigned char* wlds, const bf16_t* __restrict__ z, const Params& p, int layer, const bf16_t* __restrict__ gwt,
                                         float* __restrict__ HL, float* __restrict__ PC, float* __restrict__ sumP, float* __restrict__ sumH, int item, int lane) {
    const int fr = lane & 15, fq = lane >> 4;
    const int hh = item & 7, ck = item >> 3, T0 = ck * 128;
    const float* convw = p.in[8] + (size_t)layer * 4 * 512 + hh * 64;
    const float* convb = p.in[9] + (size_t)layer * 512 + hh * 64;
    const float* gb = p.in[11] + (size_t)layer * 1024;
    const float* lam = p.in[12] + (size_t)layer * 512 + hh * 64;
    LAS float* Al = (LAS float*)wlds; LAS float* Gl = (LAS float*)(wlds + 4224);
    float br_[4], bi_[4], sp_[4];
#pragma unroll
    for (int nt = 0; nt < 4; ++nt) { const int d = nt * 16 + fr; br_[nt] = gb[hh * 64 + d]; bi_[nt] = gb[512 + hh * 64 + d];
        const float nl = -lam[d]; sp_[nt] = (nl > 20.f) ? nl : log1pf(__expf(nl)); }
    const float w0 = convw[lane], w1 = convw[512 + lane], w2 = convw[1024 + lane], w3 = convw[1536 + lane], cb = convb[lane];
    const bf16_t* zx = z + 512 + hh * 64;
    float xm3 = (T0 >= 3) ? bf2f(zx[(size_t)(T0 - 3) * INW_ + lane]) : 0.f, xm2 = (T0 >= 2) ? bf2f(zx[(size_t)(T0 - 2) * INW_ + lane]) : 0.f, xm1 = (T0 >= 1) ? bf2f(zx[(size_t)(T0 - 1) * INW_ + lane]) : 0.f;
    float hst = 0.f, pst = 1.f;
    for (int sub = 0; sub < 8; ++sub) {
        const int t0 = T0 + sub * 16, t = t0 + fr;
        bf16x8 xf[2];
#pragma unroll
        for (int kk = 0; kk < 2; ++kk) {
            const int c0 = kk * 32 + fq * 8;
            float a[8];
            { const f32x4 b0 = *(const f32x4*)(convb + c0), b1 = *(const f32x4*)(convb + c0 + 4); a[0] = b0[0]; a[1] = b0[1]; a[2] = b0[2]; a[3] = b0[3]; a[4] = b1[0]; a[5] = b1[1]; a[6] = b1[2]; a[7] = b1[3]; }
#pragma unroll
            for (int tap = 0; tap < 4; ++tap) { const int tj = t - 3 + tap;
                const f32x4 wa = *(const f32x4*)(convw + tap * 512 + c0), wb = *(const f32x4*)(convw + tap * 512 + c0 + 4);
                bf16x8 v = (bf16x8){0, 0, 0, 0, 0, 0, 0, 0};
                if (tj >= 0) v = *(const bf16x8*)(zx + (size_t)tj * INW_ + c0);
                a[0] += wa[0] * bf2f((unsigned short)v[0]); a[1] += wa[1] * bf2f((unsigned short)v[1]); a[2] += wa[2] * bf2f((unsigned short)v[2]); a[3] += wa[3] * bf2f((unsigned short)v[3]);
                a[4] += wb[0] * bf2f((unsigned short)v[4]); a[5] += wb[1] * bf2f((unsigned short)v[5]); a[6] += wb[2] * bf2f((unsigned short)v[6]); a[7] += wb[3] * bf2f((unsigned short)v[7]); }
            u32x4 w; w.x = cvt_pk_bf16(a[0], a[1]); w.y = cvt_pk_bf16(a[2], a[3]); w.z = cvt_pk_bf16(a[4], a[5]); w.w = cvt_pk_bf16(a[6], a[7]);
            xf[kk] = __builtin_bit_cast(bf16x8, w);
        }
#pragma unroll
        for (int nt = 0; nt < 4; ++nt) {
            f32x4 ar = (f32x4){0.f, 0.f, 0.f, 0.f}, ai = (f32x4){0.f, 0.f, 0.f, 0.f};
#pragma unroll
            for (int kk = 0; kk < 2; ++kk) {
                const bf16x8 wr = *(const bf16x8*)(gwt + (size_t)(hh * 64 + nt * 16 + fr) * 64 + kk * 32 + fq * 8);
                const bf16x8 wi = *(const bf16x8*)(gwt + (size_t)((8 + hh) * 64 + nt * 16 + fr) * 64 + kk * 32 + fq * 8);
                ar = MFMA16(xf[kk], wr, ar); ai = MFMA16(xf[kk], wi, ai);
            }
#pragma unroll
            for (int j = 0; j < 4; ++j) {
                const float rg = __builtin_amdgcn_rcpf(1.0f + __expf(-(ar[j] + br_[nt]))), ig = __builtin_amdgcn_rcpf(1.0f + __expf(-(ai[j] + bi_[nt])));
                const float la = -8.0f * rg * sp_[nt];
                const float av = __expf(la), gu = sqrtf(-expm1f(2.0f * la)) * ig;
                Al[(fq * 4 + j) * 66 + nt * 16 + fr] = av; Gl[(fq * 4 + j) * 66 + nt * 16 + fr] = gu;
            }
        }
        asm volatile("s_waitcnt lgkmcnt(0)" ::: "memory");
        float xz[16];
#pragma unroll
        for (int tt = 0; tt < 16; ++tt) xz[tt] = bf2f(zx[(size_t)(t0 + tt) * INW_ + lane]);
#pragma unroll
        for (int tt = 0; tt < 16; ++tt) {
            const float xc = cb + w0 * xm3 + w1 * xm2 + w2 * xm1 + w3 * xz[tt];
            xm3 = xm2; xm2 = xm1; xm1 = xz[tt];
            const float av = Al[tt * 66 + lane], gu = Gl[tt * 66 + lane];
            hst = av * hst + gu * xc; pst = pst * av;
            HL[(size_t)(t0 + tt) * 512 + hh * 64 + lane] = hst; PC[(size_t)(t0 + tt) * 512 + hh * 64 + lane] = pst;
        }
        asm volatile("s_waitcnt lgkmcnt(0)" ::: "memory");
    }
    sumP[ck * 512 + hh * 64 + lane] = pst; sumH[ck * 512 + hh * 64 + lane] = hst;
}

__device__ __forceinline__ void mixers_phase(LAS unsigned char* lds, const Params& p, int layer) {
    const bf16_t* z = (const bf16_t*)(p.ws + OFF_HID); bf16_t* y = (bf16_t*)(p.ws + OFF_Y);
    float* HL = (float*)(p.ws + OFF_XN); float* PC = HL + (size_t)S_ * 512;
    float* sumP = (float*)(p.ws + OFF_LSUM); float* sumH = sumP + 128 * 512;
    const int tid = ltid(); const int lane = tid & 63;
    const int wid = __builtin_amdgcn_readfirstlane(tid >> 6);
    const int gwv = blockIdx.x * 8 + wid, GW = gridDim.x * 8;
    const bf16_t* pwt = (const bf16_t*)(p.ws + OFF_POOLW); const float* psc = p.in[7] + (size_t)layer * 512;
    const int G = gridDim.x;
    for (int i = blockIdx.x * 4 + wid; i < 1024; i += G * 4) {
        if (wid < 4) lru_item(lds + wid * 8448, z, p, layer, (const bf16_t*)(p.ws + OFF_GATEW), HL, PC, sumP, sumH, i, lane);
#ifdef DUP_LRU
        if (wid < 4) lru_item(lds + wid * 8448, z, p, layer, (const bf16_t*)(p.ws + OFF_GATEW), HL, PC, sumP, sumH, i, lane);
#endif
    }
    if ((G & 7) == 0) {
        const int xcd = blockIdx.x & 7, lw = (blockIdx.x >> 3) * 8 + wid, nlw = (G >> 3) * 8;
        for (int j = lw; j < 512; j += nlw) { const int head = xcd * 2 + ((j >> 2) & 1);
            attn_item(lds + wid * 8448, (const bf16_t*)(p.ws + OFF_QKV), y, j >> 3, head, j & 3, lane);
#ifdef DUP_ATT
            attn_item(lds + wid * 8448, (const bf16_t*)(p.ws + OFF_QKV), y, j >> 3, head, j & 3, lane);
#endif
        }
    } else {
        for (int i = gwv; i < 4096; i += GW) attn_item(lds + wid * 8448, (const bf16_t*)(p.ws + OFF_QKV), y, i >> 6, (i >> 2) & 15, i & 3, lane);
    }
    for (int i = gwv; i < 4096; i += GW) { const int tt = i >> 2;
        switch (i & 3) { case 0: pool_item<2>(z, y, pwt, psc, tt, lane); break; case 1: pool_item<4>(z, y, pwt, psc, tt, lane); break; case 2: pool_item<8>(z, y, pwt, psc, tt, lane); break; default: pool_item<16>(z, y, pwt, psc, tt, lane); break; }
    }
}

__device__ __forceinline__ void lru_final_phase(const Params& p) {
    const bf16_t* z = (const bf16_t*)(p.ws + OFF_HID); bf16_t* y = (bf16_t*)(p.ws + OFF_Y);
    const float* HL = (const float*)(p.ws + OFF_XN); const float* PC = HL + (size_t)S_ * 512;
    const float* sumP = (const float*)(p.ws + OFF_LSUM); const float* sumH = sumP + 128 * 512;
    const int d = ltid();
    for (int it = blockIdx.x; it < 256; it += gridDim.x) {
        const int ck = it >> 1, t0 = it * 64;
        float carry = 0.f;
#pragma unroll 8
        for (int c = 0; c < ck; ++c) carry = sumP[c * 512 + d] * carry + sumH[c * 512 + d];
#pragma unroll 8
        for (int tt = 0; tt < 64; ++tt) { const size_t t = (size_t)(t0 + tt);
            const float hv = HL[t * 512 + d] + PC[t * 512 + d] * carry;
            const float g = bf2f(z[t * INW_ + 1024 + d]);
            const float u = 0.7978845608f * (g + 0.044715f * g * g * g);
            const float th = 1.0f - 2.0f * __builtin_amdgcn_rcpf(1.0f + __expf(2.0f * u));
            const float ge = 0.5f * g * (1.0f + th);
            y[t * D_ + 512 + d] = (bf16_t)(cvt_pk_bf16(hv * ge, 0.f) & 0xffffu); }
    }
}

__global__ void __launch_bounds__(512, 2) mk_fwd(Params p, int ph_lo, int ph_hi) {
    extern __shared__ __attribute__((aligned(16))) unsigned char shm[];
    LAS unsigned char* lds = (LAS unsigned char*)shm;
    cg::grid_group grid = cg::this_grid();
    unsigned char* ws = p.ws;
    volatile LAS unsigned* bst = (volatile LAS unsigned*)(lds + 131072);
    if (threadIdx.x < 4) bst[threadIdx.x] = 0u;
    __syncthreads();
    XcdBarrier bar = xcd_barrier_post((unsigned*)(ws + OFF_BAR), bst);
    bf16_t* XN = (bf16_t*)(ws + OFF_XN); bf16_t* HID = (bf16_t*)(ws + OFF_HID); bf16_t* H = (bf16_t*)(ws + OFF_H); bf16_t* Y = (bf16_t*)(ws + OFF_Y);
    for (int ph = ph_lo; ph < ph_hi; ++ph) {
#ifdef DUP_MASK
      for (int rep = 0; rep < ((ph > 0 && ((DUP_MASK >> ((ph - 1) % 11)) & 1)) ? 2 : 1); ++rep)
#endif
        if (ph == 0) {
            convert_phase(lds, p, 0);
#ifdef DUP_CONV
            convert_phase(lds, p, 0); convert_phase(lds, p, 0);
#endif
            norm_phase(nullptr, p.in[0], nullptr, 0.f, nullptr, p.in[1], XN);
        } else {
            const int layer = (ph - 1) / 11, st = (ph - 1) % 11;
            const float* g = p.in[1] + (size_t)layer * 6 * D_;
            if (st == 0 || st == 8) {
                pg8::Gemm gm; gm.A = XN; gm.Bt = (const bf16_t*)(ws + (st == 0 ? OFF_W1IN : OFF_W2IN)); gm.M = S_; gm.N = 2 * DFF_; gm.K = D_;
                pg8::StaticOrder so; so.init(gm.M, gm.N, (int)gridDim.x, (int)blockIdx.x);
                pg8::EpiSwiGLU e; e.O = HID; e.ldc = DFF_;
                #ifndef NO_G1
                pg8::gemm_phase<pg8::EpiSwiGLU, pg8::StaticOrder, true, true>(lds, gm, so, e);
#endif
            } else if (st == 1 || st == 9 || st == 6 || st == 3) {
                pg8::Gemm gm; gm.M = S_; pg8::EpiBf16P e;
                e.QKV = nullptr;
                if (st == 3) { gm.A = XN; gm.Bt = (const bf16_t*)(ws + OFF_WMIN); gm.N = INW_; gm.K = D_; e.O = HID; e.ldc = INW_; e.QKV = (bf16_t*)(ws + OFF_QKV); }
                else if (st == 6) { gm.A = Y; gm.Bt = (const bf16_t*)(ws + OFF_WMOUT); gm.N = D_; gm.K = D_; e.O = H; e.ldc = D_; }
                else { gm.A = HID; gm.Bt = (const bf16_t*)(ws + (st == 1 ? OFF_W1OUT : OFF_W2OUT)); gm.N = D_; gm.K = DFF_; e.O = H; e.ldc = D_; }
                pg8::StaticOrder so; so.init(gm.M, gm.N, (int)gridDim.x, (int)blockIdx.x);
                pg8::gemm_phase<pg8::EpiBf16P, pg8::StaticOrder, true, true>(lds, gm, so, e);
            } else if (st == 2) {
#ifdef DUP_NORM
                norm_phase(H, layer == 0 ? p.in[0] : p.out, (float*)HID, 0.5f, g + 1 * D_, g + 2 * D_, XN);
#endif
                norm_phase(H, layer == 0 ? p.in[0] : p.out, p.out, 0.5f, g + 1 * D_, g + 2 * D_, XN);
            } else if (st == 7) {
#ifdef DUP_NORM
                norm_phase(H, p.out, (float*)HID, 1.0f, g + 3 * D_, g + 4 * D_, XN);
#endif
                norm_phase(H, p.out, p.out, 1.0f, g + 3 * D_, g + 4 * D_, XN);
            } else if (st == 10) {
                const bool more = (layer + 1 < DEPTH_);
                norm_phase(H, p.out, p.out, 0.5f, g + 5 * D_, more ? g + 6 * D_ : nullptr, more ? XN : nullptr);
                if (more) convert_phase(lds, p, layer + 1);
            } else if (st == 4) {
#ifndef NO_MIX
                mixers_phase(lds, p, layer);
#endif
            } else {
                lru_final_phase(p);
            }
        }
        if (ph + 1 < ph_hi) { if (ph == ph_lo) grid.sync(); else xcd_barrier(bar); }
    }
}

#ifndef MK_COOP
#define MK_COOP 1
#endif
extern "C" void kernel_launch(void* const* d_in, const int* in_sizes, int n_in, void* d_out, int out_size, void* d_ws, size_t ws_size, hipStream_t stream) {
    static int grid_blocks = 0;
    if (!grid_blocks) {
        if (n_in != 15 || out_size != S_ * D_ || ws_size < WS_END) { fprintf(stderr, "kernel_launch: unexpected shapes (n_in %d out %d ws %zu need %zu)\n", n_in, out_size, ws_size, (size_t)WS_END); grid_blocks = -1; return; }
        int dev = 0, cus = 0, per_cu = 0;
        hipGetDevice(&dev);
        hipDeviceGetAttribute(&cus, hipDeviceAttributeMultiprocessorCount, dev);
        if (hipFuncSetAttribute((const void*)mk_fwd, hipFuncAttributeMaxDynamicSharedMemorySize, LDS_BYTES) != hipSuccess) { fprintf(stderr, "kernel_launch: hipFuncSetAttribute failed\n"); grid_blocks = -1; return; }
        hipOccupancyMaxActiveBlocksPerMultiprocessor(&per_cu, (const void*)mk_fwd, 512, LDS_BYTES);
        if (per_cu < 1) { fprintf(stderr, "kernel_launch: occupancy query says %d\n", per_cu); per_cu = 1; }
        (void)hipGetLastError();
        grid_blocks = cus * per_cu;
    }
    if (grid_blocks < 0) return;
    (void)hipMemsetAsync((unsigned char*)d_ws + OFF_BAR, 0, 16384, stream);
    Params p{};
    for (int i = 0; i < 15; ++i) p.in[i] = (const float*)d_in[i];
    p.out = (float*)d_out; p.ws = (unsigned char*)d_ws;
#if MK_COOP
    int lo = 0, hi = NPHASE;
    void* args[] = {&p, &lo, &hi};
    hipError_t e = hipLaunchCooperativeKernel((const void*)mk_fwd, dim3(grid_blocks), dim3(512), args, LDS_BYTES, stream);
    if (e != hipSuccess) fprintf(stderr, "cooperative launch failed: %s (grid %d)\n", hipGetErrorString(e), grid_blocks);
#else
    for (int ph = 0; ph < NPHASE; ++ph) hipLaunchKernelGGL(mk_fwd, dim3(grid_blocks), dim3(512), LDS_BYTES, stream, p, ph, ph + 1);
#endif
}
```

```cpp
#include <hip/hip_runtime.h>
#include <hip/hip_cooperative_groups.h>
#include <cstdio>
namespace cg = cooperative_groups;
#define XB_TMO      128
#define XB_XCNT(j)  (256  + 64 * (j))
#define XB_XSUB(j)  (1280 + 64 * (j))
#define XB_XGEN(j)  (2304 + 64 * (j))
#define XB_TOP      3328
#define XB_TOPGEN   3392
#define XCD_BAR_WORDS 3456
#define XB_SPIN_CAP (1u << 18)
#define LAS __attribute__((address_space(3)))

__device__ __forceinline__ unsigned xb_ld(unsigned* p)              { return __hip_atomic_load(p, __ATOMIC_RELAXED, __HIP_MEMORY_SCOPE_AGENT); }
__device__ __forceinline__ unsigned xb_add(unsigned* p, unsigned v) { return __hip_atomic_fetch_add(p, v, __ATOMIC_RELAXED, __HIP_MEMORY_SCOPE_AGENT); }
__device__ __forceinline__ unsigned xb_xcc_id() { return (unsigned)__builtin_amdgcn_s_getreg((3 << 11) | 20) & 0xFu; }
#define XB_SPIN(cond, bar) do { unsigned _sp = 0; while (cond) { __builtin_amdgcn_s_sleep(1); \
    if ((++_sp & 255u) == 0u) { if (xb_ld(&(bar)[XB_TMO])) break; if (_sp > XB_SPIN_CAP) { atomicAdd(&(bar)[XB_TMO], 1u); break; } } } } while (0)

struct XcdBarrier {
    unsigned* bar; unsigned x;
    volatile LAS unsigned* st;
};

__device__ __forceinline__ XcdBarrier xcd_barrier_post(unsigned* bar, volatile LAS unsigned* st) {
    XcdBarrier b; b.bar = bar; b.x = xb_xcc_id(); b.st = st;
    if (threadIdx.x == 0) (void)xb_add(&bar[XB_XCNT(b.x)], 1u);
    return b;
}
__device__ __forceinline__ void xcd_barrier_complete(unsigned* bar, unsigned x, unsigned& nloc, unsigned& nx) {
    const unsigned G = gridDim.x * gridDim.y * gridDim.z;
    unsigned sum, cnt, mine, sp = 0u;
    for (;;) {
        sum = 0u; cnt = 0u; mine = 0u;
#pragma unroll
        for (unsigned j = 0; j < 16; ++j) { const unsigned c = xb_ld(&bar[XB_XCNT(j)]); sum += c; cnt += (c > 0u) ? 1u : 0u; mine = (j == x) ? c : mine; }
        if (sum == G) break;
        __builtin_amdgcn_s_sleep(1);
        if ((++sp & 255u) == 0u) { if (xb_ld(&bar[XB_TMO])) break; if (sp > XB_SPIN_CAP) { atomicAdd(&bar[XB_TMO], 1u); break; } }
    }
    nloc = mine > 0u ? mine : 1u; nx = cnt > 0u ? cnt : 1u;
}

__device__ __forceinline__ void xcd_barrier(const XcdBarrier& b) {
    asm volatile("s_waitcnt vmcnt(0)" ::: "memory");
    __syncthreads();
    if (threadIdx.x == 0) {
        unsigned* bar = b.bar;
        __builtin_amdgcn_s_waitcnt(0);
        unsigned nloc = b.st[0], nx = b.st[1];
        if (nloc == 0u) { xcd_barrier_complete(bar, b.x, nloc, nx); b.st[0] = nloc; b.st[1] = nx; }
        const unsigned old = xb_add(&bar[XB_XSUB(b.x)], 1u);
        const unsigned gen = old / nloc;
        if (old + 1u == (gen + 1u) * nloc) {
            __builtin_amdgcn_fence(__ATOMIC_RELEASE, "agent");
            asm volatile("s_waitcnt vmcnt(0)" ::: "memory");
            const unsigned og = xb_add(&bar[XB_TOP], 1u);
            const unsigned tg = og / nx;
            if (og + 1u == (tg + 1u) * nx) xb_add(&bar[XB_TOPGEN], 1u);
            else XB_SPIN(xb_ld(&bar[XB_TOPGEN]) == tg, bar);
            __builtin_amdgcn_fence(__ATOMIC_ACQUIRE, "agent");
            xb_add(&bar[XB_XGEN(b.x)], 1u);
            asm volatile("s_waitcnt vmcnt(0)" ::: "memory");
        } else {
            XB_SPIN(xb_ld(&bar[XB_XGEN(b.x)]) == gen, bar);
            __builtin_amdgcn_fence(__ATOMIC_ACQUIRE, "agent");
            asm volatile("s_waitcnt vmcnt(0)" ::: "memory");
        }
    }
    __syncthreads();
}
#include <hip/hip_runtime.h>
namespace pg8 {
#define PG8_LAS __attribute__((address_space(3)))
typedef unsigned short bf16_t;
typedef short bf16x8 __attribute__((ext_vector_type(8)));
typedef float f32x4 __attribute__((ext_vector_type(4)));
typedef unsigned u32x4 __attribute__((ext_vector_type(4)));
constexpr int BM = 256, BK = 64, HALF = 128, HTB = HALF * BK * 2  , STAGE_BYTES = 8 * HTB, NXCD = 8, WGM = 8;

__host__ __device__ __forceinline__ int lds_byte(int r, int c) { const int st = (r >> 4) * 2 + (c >> 5), rr = r & 15, cc = c & 31, ob = rr * 64 + cc * 2; return st * 1024 + (ob ^ (((ob >> 9) & 1) << 5)); }
__host__ __device__ __forceinline__ void stage_rc(int b, int& R, int& C) { const int st = b / 1024, sb = b % 1024, swz = sb ^ (((sb >> 9) & 1) << 5); R = (st >> 1) * 16 + swz / 64; C = (st & 1) * 32 + (swz % 64) / 2; }
__host__ __device__ __forceinline__ int perm32(int rho) { const int n = rho >> 4, i = rho & 15; return 8 * (i >> 2) + 4 * n + (i & 3); }

struct Unit { int pm, pn; };
struct Gemm { const bf16_t* A; const bf16_t* Bt; int M, N, K; };

struct StaticOrder {
    int nM, nN, nwg, G, c;
    __host__ __device__ void init(int M, int N, int G_, int c_) { nM = M / BM; nN = N / BM; nwg = nM * nN; G = G_; c = c_; }
    __host__ __device__ bool next(int i, Unit& u) const {
        const long L = (long)i * G + c; if (L >= nwg) return false;
        int wgid = (int)L; { const int q = nwg / NXCD, r = nwg % NXCD, xcd = wgid % NXCD, off = wgid / NXCD; wgid = (xcd < r ? xcd * (q + 1) : r * (q + 1) + (xcd - r) * q) + off; }
        const int nig = WGM * nN, gid = wgid / nig, fm = gid * WGM, gsz = (nM - fm) < WGM ? (nM - fm) : WGM;
        u.pm = fm + ((wgid % nig) % gsz); u.pn = (wgid % nig) / gsz; return true;
    }
    __device__ __forceinline__ void a_ready(const Unit&) const {}
    __device__ __forceinline__ void done(const Unit&) const {}
};
__device__ __forceinline__ unsigned cvt_pk_bf16(float lo, float hi) { unsigned r; asm volatile("v_cvt_pk_bf16_f32 %0, %1, %2" : "=v"(r) : "v"(lo), "v"(hi)); return r; }
struct EpiF32 {
    static constexpr bool PERM = false, AFTER_DRAIN = false;
    float* C; int ldc; const float* bias;
    __device__ __forceinline__ void operator()(const f32x4 (&acc)[2][2][4][2], const Unit& u, int wr, int wc, int fr, int fq) const {
        const int row0 = u.pm * BM + wr * 64 + fr, col0 = u.pn * BM + wc * 32 + 4 * fq;
        f32x4 bv[2][2];
#pragma unroll
        for (int bj = 0; bj < 2; ++bj)
#pragma unroll
            for (int n = 0; n < 2; ++n) bv[bj][n] = bias ? *(const f32x4*)(bias + col0 + bj * HALF + n * 16) : (f32x4){0.f, 0.f, 0.f, 0.f};
#pragma unroll
        for (int ai = 0; ai < 2; ++ai)
#pragma unroll
            for (int m = 0; m < 4; ++m) { float* rowp = C + (size_t)(row0 + ai * HALF + m * 16) * ldc + col0;
#pragma unroll
                for (int bj = 0; bj < 2; ++bj)
#pragma unroll
                    for (int n = 0; n < 2; ++n) *(f32x4*)(rowp + bj * HALF + n * 16) = acc[ai][bj][m][n] + bv[bj][n]; }
    }
};
typedef unsigned u32x2 __attribute__((ext_vector_type(2)));
struct EpiBf16P {
    static constexpr bool PERM = true, AFTER_DRAIN = false;
    bf16_t* O; int ldc; bf16_t* QKV; const float* RS;
    __device__ __forceinline__ void operator()(const f32x4 (&acc)[2][2][4][2], const Unit& u, int wr, int wc, int fr, int fq) const {
        const int row0 = u.pm * BM + wr * 64 + fr, col0 = u.pn * BM + wc * 32 + 8 * fq;
        const bool redir = (QKV != nullptr) && (u.pn >= 6);
        const int hd0 = (((u.pn - 6) >> 2) * 16 + ((u.pn - 6) & 3) * 4 + (wc >> 1));
        float rsv[8];
#pragma unroll
        for (int q = 0; q < 8; ++q) rsv[q] = RS ? RS[row0 + (q >> 2) * HALF + (q & 3) * 16] : 1.0f;
        if (RS) asm volatile("" :: "v"(rsv[0]), "v"(rsv[1]), "v"(rsv[2]), "v"(rsv[3]), "v"(rsv[4]), "v"(rsv[5]), "v"(rsv[6]), "v"(rsv[7]));
#pragma unroll
        for (int ai = 0; ai < 2; ++ai)
#pragma unroll
            for (int m = 0; m < 4; ++m) { const int row = row0 + ai * HALF + m * 16; const float rsc = rsv[ai * 4 + m];
                bf16_t* rowp = redir ? QKV + ((size_t)hd0 * 16384 + row) * 64 + (wc & 1) * 32 + 8 * fq : O + (size_t)row * ldc + col0;
                const size_t bjstep = redir ? (size_t)2 * 16384 * 64 : (size_t)HALF;
#pragma unroll
                for (int bj = 0; bj < 2; ++bj) { const f32x4 v0 = acc[ai][bj][m][0] * rsc, v1 = acc[ai][bj][m][1] * rsc;
                    u32x4 w; w.x = cvt_pk_bf16(v0[0], v0[1]); w.y = cvt_pk_bf16(v0[2], v0[3]); w.z = cvt_pk_bf16(v1[0], v1[1]); w.w = cvt_pk_bf16(v1[2], v1[3]);
                    *(u32x4*)(rowp + bj * bjstep) = w; } }
    }
};
__device__ __forceinline__ float silu_mul(float g, float u) { return g * u * __builtin_amdgcn_rcpf(1.0f + __expf(-g)); }
struct EpiSwiGLU {
    static constexpr bool PERM = true, AFTER_DRAIN = false;
    bf16_t* O; int ldc; const float* RS;
    __device__ __forceinline__ void operator()(const f32x4 (&acc)[2][2][4][2], const Unit& u, int wr, int wc, int fr, int fq) const {
        const int row0 = u.pm * BM + wr * 64 + fr, col0 = u.pn * HALF + wc * 32 + 8 * fq;
        float rsv[8];
#pragma unroll
        for (int q = 0; q < 8; ++q) rsv[q] = RS[row0 + (q >> 2) * HALF + (q & 3) * 16];
        asm volatile("" :: "v"(rsv[0]), "v"(rsv[1]), "v"(rsv[2]), "v"(rsv[3]), "v"(rsv[4]), "v"(rsv[5]), "v"(rsv[6]), "v"(rsv[7]));
#pragma unroll
        for (int ai = 0; ai < 2; ++ai)
#pragma unroll
            for (int m = 0; m < 4; ++m) { bf16_t* rowp = O + (size_t)(row0 + ai * HALF + m * 16) * ldc + col0; const float rsc = rsv[ai * 4 + m];
                const f32x4 g0 = acc[ai][0][m][0] * rsc, g1 = acc[ai][0][m][1] * rsc, u0 = acc[ai][1][m][0] * rsc, u1 = acc[ai][1][m][1] * rsc;
                u32x4 w; w.x = cvt_pk_bf16(silu_mul(g0[0], u0[0]), silu_mul(g0[1], u0[1])); w.y = cvt_pk_bf16(silu_mul(g0[2], u0[2]), silu_mul(g0[3], u0[3]));
                w.z = cvt_pk_bf16(silu_mul(g1[0], u1[0]), silu_mul(g1[1], u1[1])); w.w = cvt_pk_bf16(silu_mul(g1[2], u1[2]), silu_mul(g1[3], u1[3]));
                *(u32x4*)rowp = w; }
    }
};

template <class Epi, class Sched, bool ALIGN_EPI = false, bool SP2 = false>
__device__ __forceinline__ void gemm_phase(PG8_LAS unsigned char* lds, const Gemm g, const Sched& S, const Epi& E) {
    int tid_l = threadIdx.x; asm volatile("" : "+v"(tid_l));
    const int tid = tid_l, wid = __builtin_amdgcn_readfirstlane(tid >> 6), lane = tid & 63, wr = wid >> 2, wc = wid & 3, fr = lane & 15, fq = lane >> 4;
    const int K = g.K, nt = K / BK;
    unsigned voffA[2], voffB[2];
#pragma unroll
    for (int i = 0; i < 2; ++i) { int R, C; stage_rc(tid * 16 + i * 8192, R, C); const int Rb = Epi::PERM ? ((R & ~31) + perm32(R & 31)) : R;
        voffA[i] = (unsigned)(R * K + C) * 2u; voffB[i] = (unsigned)(Rb * K + C) * 2u; }
    const size_t kstep = (size_t)(BK * 2);
    const size_t hstep = (size_t)HALF * K * 2;
    const size_t tstep = 2 * hstep;
    const unsigned ldsw = (unsigned)wid * 1024u;
    const int aoff = lds_byte(wr * 64 + fr, fq * 8), boff = lds_byte(wc * 32 + fr, fq * 8);
#define PG8_SA(b, h) (((b) * 2 + (h)) * HTB)
#define PG8_SB(b, h) ((4 + (b) * 2 + (h)) * HTB)
#define PG8_STAGE(bufoff, gbase, voff) do { _Pragma("unroll") for (int _i = 0; _i < 2; ++_i) \
        __builtin_amdgcn_global_load_lds((const unsigned*)((const char*)(gbase) + (voff)[_i]), (PG8_LAS unsigned*)(lds + (bufoff) + ldsw + _i * 8192), 16, 0, 0); } while (0)
#define PG8_LDA(dst, b, h) do { _Pragma("unroll") for (int m = 0; m < 4; ++m) _Pragma("unroll") for (int k = 0; k < 2; ++k) dst[m][k] = *(const PG8_LAS bf16x8*)(lds + PG8_SA(b, h) + aoff + m * 2048 + k * 1024); } while (0)
#define PG8_LDB(dst, b, h) do { _Pragma("unroll") for (int n = 0; n < 2; ++n) _Pragma("unroll") for (int k = 0; k < 2; ++k) dst[n][k] = *(const PG8_LAS bf16x8*)(lds + PG8_SB(b, h) + boff + n * 2048 + k * 1024); } while (0)
#define PG8_MMA(ai, bj, At, Bt) do { __builtin_amdgcn_s_setprio(1); _Pragma("unroll") for (int m = 0; m < 4; ++m) _Pragma("unroll") for (int n = 0; n < 2; ++n) _Pragma("unroll") for (int k = 0; k < 2; ++k) \
        acc[ai][bj][m][n] = __builtin_amdgcn_mfma_f32_16x16x32_bf16(Bt[n][k], At[m][k], acc[ai][bj][m][n], 0, 0, 0); __builtin_amdgcn_s_setprio(0); } while (0)
#define PG8_WAIT_V(n) asm volatile("s_waitcnt vmcnt(" #n ")" ::: "memory")
#define PG8_WAIT_L(n) asm volatile("s_waitcnt lgkmcnt(" #n ")" ::: "memory")
#define PG8_BAR __builtin_amdgcn_s_barrier()
#define PG8_SCHED __builtin_amdgcn_sched_barrier(0)
    Unit cur, nxt; int ui = 0;
    if (!S.next(0, cur)) return;
    f32x4 acc[2][2][4][2];
#pragma unroll
    for (int a = 0; a < 2; ++a)
#pragma unroll
        for (int b = 0; b < 2; ++b)
#pragma unroll
            for (int m = 0; m < 4; ++m)
#pragma unroll
                for (int n = 0; n < 2; ++n) acc[a][b][m][n] = (f32x4){0.f, 0.f, 0.f, 0.f};
    bf16x8 At[4][2], B0[2][2], B1[2][2];
    const char* cA = (const char*)g.A + (size_t)cur.pm * tstep; const char* cB = (const char*)g.Bt + (size_t)cur.pn * tstep;
    S.a_ready(cur);
    if constexpr (SP2) {
        PG8_STAGE(PG8_SB(0, 0), cB, voffB); PG8_STAGE(PG8_SB(0, 1), cB + hstep, voffB); PG8_STAGE(PG8_SA(0, 0), cA, voffA); PG8_STAGE(PG8_SA(0, 1), cA + hstep, voffA);
        if (wr == 1) PG8_BAR;
        PG8_WAIT_V(2); PG8_BAR;
        PG8_STAGE(PG8_SB(1, 0), cB + kstep, voffB); PG8_STAGE(PG8_SA(1, 0), cA + kstep, voffA); PG8_STAGE(PG8_SB(1, 1), cB + hstep + kstep, voffB);
        PG8_WAIT_V(6); PG8_BAR;
    } else {
        PG8_STAGE(PG8_SB(0, 0), cB, voffB); PG8_STAGE(PG8_SA(0, 0), cA, voffA); PG8_STAGE(PG8_SB(0, 1), cB + hstep, voffB); PG8_STAGE(PG8_SA(0, 1), cA + hstep, voffA);
        if (wr == 1) PG8_BAR;
        PG8_WAIT_V(4); PG8_BAR;
        PG8_STAGE(PG8_SB(1, 0), cB + kstep, voffB); PG8_STAGE(PG8_SA(1, 0), cA + kstep, voffA); PG8_STAGE(PG8_SB(1, 1), cB + hstep + kstep, voffB);
        PG8_WAIT_V(6); PG8_BAR;
    }
    for (;;) {
        const bool has_next = S.next(ui + 1, nxt);
        const char* nA = has_next ? (const char*)g.A + (size_t)nxt.pm * tstep : cA; const char* nB = has_next ? (const char*)g.Bt + (size_t)nxt.pn * tstep : cB;
        for (int t = 0; t < nt; t += 2) {
            const bool last = (t == nt - 2);
            const char* a1 = cA + (size_t)(t + 1) * kstep;
            const char* a2 = last ? nA : cA + (size_t)(t + 2) * kstep; const char* b2 = last ? nB : cB + (size_t)(t + 2) * kstep;
            const char* a3 = a2 + kstep; const char* b3 = b2 + kstep;
            if (last && has_next) S.a_ready(nxt);
            if constexpr (SP2) {
            PG8_LDB(B0, 0, 0); PG8_LDB(B1, 0, 1); PG8_SCHED; PG8_LDA(At, 0, 0); PG8_STAGE(PG8_SA(1, 1), a1 + hstep, voffA);
            PG8_WAIT_V(8); PG8_WAIT_L(0); PG8_BAR; PG8_MMA(0, 0, At, B0); PG8_MMA(0, 1, At, B1); PG8_BAR; PG8_SCHED;
            PG8_LDA(At, 0, 1); PG8_STAGE(PG8_SB(0, 0), b2, voffB); PG8_STAGE(PG8_SB(0, 1), b2 + hstep, voffB); PG8_STAGE(PG8_SA(0, 0), a2, voffA);
            PG8_WAIT_V(8); PG8_WAIT_L(0); PG8_BAR; PG8_MMA(1, 0, At, B0); PG8_MMA(1, 1, At, B1); PG8_BAR; PG8_SCHED;
            PG8_LDB(B0, 1, 0); PG8_LDB(B1, 1, 1); PG8_SCHED; PG8_LDA(At, 1, 0); PG8_STAGE(PG8_SA(0, 1), a2 + hstep, voffA);
            PG8_WAIT_V(8); PG8_WAIT_L(0); PG8_BAR; PG8_MMA(0, 0, At, B0); PG8_MMA(0, 1, At, B1); PG8_BAR; PG8_SCHED;
            PG8_LDA(At, 1, 1); PG8_STAGE(PG8_SB(1, 0), b3, voffB); PG8_STAGE(PG8_SB(1, 1), b3 + hstep, voffB); PG8_STAGE(PG8_SA(1, 0), a3, voffA);
            PG8_WAIT_V(8); PG8_WAIT_L(0); PG8_BAR; PG8_MMA(1, 0, At, B0); PG8_MMA(1, 1, At, B1); PG8_BAR; PG8_SCHED;
            } else {
            PG8_LDB(B0, 0, 0); PG8_SCHED; PG8_LDA(At, 0, 0); PG8_STAGE(PG8_SA(1, 1), a1 + hstep, voffA);
            PG8_WAIT_L(8); PG8_BAR; PG8_WAIT_L(0); PG8_MMA(0, 0, At, B0); PG8_BAR; PG8_SCHED;
            PG8_LDB(B1, 0, 1); PG8_STAGE(PG8_SB(0, 0), b2, voffB);
            PG8_BAR; PG8_WAIT_L(0); PG8_MMA(0, 1, At, B1); PG8_BAR;
            PG8_LDA(At, 0, 1); PG8_STAGE(PG8_SA(0, 0), a2, voffA);
            PG8_BAR; PG8_WAIT_L(0); PG8_MMA(1, 0, At, B0); PG8_BAR; PG8_SCHED;
            PG8_STAGE(PG8_SB(0, 1), b2 + hstep, voffB);
            PG8_WAIT_V(6); PG8_BAR; PG8_MMA(1, 1, At, B1); PG8_BAR;
            PG8_LDB(B0, 1, 0); PG8_SCHED; PG8_LDA(At, 1, 0); PG8_STAGE(PG8_SA(0, 1), a2 + hstep, voffA);
            PG8_WAIT_L(8); PG8_BAR; PG8_WAIT_L(0); PG8_MMA(0, 0, At, B0); PG8_BAR; PG8_SCHED;
            PG8_LDB(B1, 1, 1); PG8_STAGE(PG8_SB(1, 0), b3, voffB);
            PG8_BAR; PG8_WAIT_L(0); PG8_MMA(0, 1, At, B1); PG8_BAR;
            PG8_LDA(At, 1, 1); PG8_STAGE(PG8_SA(1, 0), a3, voffA);
            PG8_BAR; PG8_WAIT_L(0); PG8_MMA(1, 0, At, B0); PG8_BAR; PG8_SCHED;
            PG8_STAGE(PG8_SB(1, 1), b3 + hstep, voffB);
            PG8_WAIT_V(6); PG8_BAR; PG8_MMA(1, 1, At, B1); PG8_BAR;
            }
        }
        if constexpr (ALIGN_EPI) { if (wr == 0) PG8_BAR; }
        if constexpr (!Epi::AFTER_DRAIN) { E(acc, cur, wr, wc, fr, fq); S.done(cur); }
        if (!has_next) break;
#pragma unroll
        for (int a = 0; a < 2; ++a)
#pragma unroll
            for (int b = 0; b < 2; ++b)
#pragma unroll
                for (int m = 0; m < 4; ++m)
#pragma unroll
                    for (int n = 0; n < 2; ++n) acc[a][b][m][n] = (f32x4){0.f, 0.f, 0.f, 0.f};
        cur = nxt; cA = nA; cB = nB; ++ui;
        if constexpr (ALIGN_EPI) { if (wr == 1) PG8_BAR; }
    }
    PG8_WAIT_V(0);
    if constexpr (!ALIGN_EPI) { if (wr == 0) PG8_BAR; }
    PG8_BAR;
    if constexpr (Epi::AFTER_DRAIN) { E.fused(acc, cur, wr, wc, fr, fq, lds, wid, lane); S.done(cur); }
#undef PG8_SA
#undef PG8_SB
#undef PG8_STAGE
#undef PG8_LDA
#undef PG8_LDB
#undef PG8_MMA
#undef PG8_WAIT_V
#undef PG8_WAIT_L
#undef PG8_BAR
#undef PG8_SCHED
}
}

using pg8::bf16_t; using pg8::bf16x8; using pg8::f32x4; using pg8::u32x4; using pg8::u32x2; using pg8::cvt_pk_bf16;

constexpr int S_ = 16384, D_ = 2048, DFF_ = 5632, INW_ = 4608, DEPTH_ = 2;
constexpr int LDS_BYTES = 131072 + 16;
constexpr size_t SZ_WIN = (size_t)2 * DFF_ * D_ * 2, SZ_WOUT = (size_t)D_ * DFF_ * 2, SZ_WMIN = (size_t)INW_ * D_ * 2, SZ_WMOUT = (size_t)D_ * D_ * 2;
constexpr size_t OFF_W1IN = 0, OFF_W1OUT = OFF_W1IN + SZ_WIN, OFF_WMIN = OFF_W1OUT + SZ_WOUT, OFF_WMOUT = OFF_WMIN + SZ_WMIN, OFF_W2IN = OFF_WMOUT + SZ_WMOUT, OFF_W2OUT = OFF_W2IN + SZ_WIN;
constexpr size_t OFF_POOLW = OFF_W2OUT + SZ_WOUT, OFF_GATEW = OFF_POOLW + 131072, OFF_LSUM = OFF_GATEW + 131072;
constexpr size_t OFF_XN = OFF_LSUM + 524288, OFF_HID = OFF_XN + (size_t)S_ * D_ * 2, OFF_H = OFF_HID + (size_t)S_ * DFF_ * 2, OFF_Y = OFF_H + (size_t)S_ * D_ * 2, OFF_BAR = OFF_Y + (size_t)S_ * D_ * 2, OFF_TS = OFF_BAR + 16384, OFF_RS = OFF_TS + 1024, OFF_QKV = OFF_RS + 65536, WS_END = OFF_QKV + (size_t)3 * 16 * S_ * 64 * 2;
constexpr int NPHASE = 1 + 11 * DEPTH_;

struct Params { const float* in[15]; float* out; unsigned char* ws; };

__device__ __forceinline__ int ltid() { int t = threadIdx.x; asm volatile("" : "+v"(t)); return t; }
__device__ __forceinline__ float bf2f(unsigned short b) { return __uint_as_float(((unsigned)b) << 16); }
__device__ __forceinline__ float wave_sum(float v) {
#pragma unroll
    for (int o = 32; o > 0; o >>= 1) v += __shfl_xor(v, o);
    return v;
}

__device__ __forceinline__ void convert_tile(LAS unsigned char* lds, const float* __restrict__ src, bf16_t* __restrict__ dst, int K, int srcN, int perm, int nt_idx, int kt_idx, int tid, const float* __restrict__ gk) {
    const int n = tid & 63, kg = tid >> 6;
    const int np0 = nt_idx * 64;
    int sc0 = np0;
    if (perm) { const int pn = np0 >> 8, bj = (np0 >> 7) & 1, j = np0 & 127; sc0 = bj * DFF_ + pn * 128 + j; }
    const float* s = src + (size_t)(kt_idx * 128 + kg * 16) * srcN + sc0 + n;
    float v[16];
#pragma unroll
    for (int i = 0; i < 16; ++i) v[i] = __builtin_nontemporal_load(s + (size_t)i * srcN);
    if (gk) {
#pragma unroll
        for (int i = 0; i < 16; ++i) v[i] *= gk[kt_idx * 128 + __builtin_amdgcn_readfirstlane(kg) * 16 + i]; }
#pragma unroll
    for (int i = 0; i < 4; ++i) { u32x2 w; w.x = cvt_pk_bf16(v[i * 4], v[i * 4 + 1]); w.y = cvt_pk_bf16(v[i * 4 + 2], v[i * 4 + 3]);
        *(LAS u32x2*)(lds + n * 264 + (kg * 4 + i) * 8) = w; }
    __syncthreads();
#pragma unroll
    for (int pass = 0; pass < 2; ++pass) { const int row = pass * 32 + (tid >> 4), c = tid & 15;
        const u32x2 a = *(const LAS u32x2*)(lds + row * 264 + c * 16), b = *(const LAS u32x2*)(lds + row * 264 + c * 16 + 8);
        u32x4 o; o.x = a.x; o.y = a.y; o.z = b.x; o.w = b.y;
        *(u32x4*)(dst + (size_t)(np0 + row) * K + kt_idx * 128 + c * 8) = o; }
    __syncthreads();
}

__device__ __forceinline__ void convert_phase(LAS unsigned char* lds, const Params& p, int layer) {
    unsigned char* ws = p.ws; const int tid = ltid();
    const int ntiles[6] = {2816, 1408, 1152, 512, 2816, 1408};
    int total = 0;
#pragma unroll
    for (int j = 0; j < 6; ++j) total += ntiles[j];
    for (int T = blockIdx.x; T < total; T += gridDim.x) {
        int loc = T; int job = 0;
#pragma unroll
        for (int j = 0; j < 5; ++j) if (job == j && loc >= ntiles[j]) { loc -= ntiles[j]; job = j + 1; }
        const float* src; bf16_t* dst; int K, srcN, perm, ntn; const float* gk = nullptr; const float* gl = p.in[1] + (size_t)layer * 6 * D_;
        switch (job) {
            case 0: src = p.in[2] + (size_t)layer * D_ * 2 * DFF_; dst = (bf16_t*)(ws + OFF_W1IN); K = D_; srcN = 2 * DFF_; perm = 1; ntn = 2 * DFF_ / 64; gk = gl; break;
            case 1: src = p.in[3] + (size_t)layer * DFF_ * D_; dst = (bf16_t*)(ws + OFF_W1OUT); K = DFF_; srcN = D_; perm = 0; ntn = D_ / 64; break;
            case 2: src = p.in[4] + (size_t)layer * D_ * INW_; dst = (bf16_t*)(ws + OFF_WMIN); K = D_; srcN = INW_; perm = 0; ntn = INW_ / 64; gk = gl + 2 * D_; break;
            case 3: src = p.in[5] + (size_t)layer * D_ * D_; dst = (bf16_t*)(ws + OFF_WMOUT); K = D_; srcN = D_; perm = 0; ntn = D_ / 64; break;
            case 4: src = p.in[13] + (size_t)layer * D_ * 2 * DFF_; dst = (bf16_t*)(ws + OFF_W2IN); K = D_; srcN = 2 * DFF_; perm = 1; ntn = 2 * DFF_ / 64; gk = gl + 4 * D_; break;
            default: src = p.in[14] + (size_t)layer * DFF_ * D_; dst = (bf16_t*)(ws + OFF_W2OUT); K = DFF_; srcN = D_; perm = 0; ntn = D_ / 64; break;
        }
        const int kt = loc / ntn, nt = loc - kt * ntn;
        convert_tile(lds, src, dst, K, srcN, perm, nt, kt, tid, gk);
    }
    const float* pw = p.in[6] + (size_t)layer * 65536; const float* gw = p.in[10] + (size_t)layer * 65536;
    bf16_t* pwt = (bf16_t*)(ws + OFF_POOLW); bf16_t* gwt = (bf16_t*)(ws + OFF_GATEW);
    for (int i = blockIdx.x * 512 + tid; i < 131072; i += gridDim.x * 512) {
        if (i < 65536) { const int g = i >> 14, d = (i >> 7) & 127, c = i & 127; pwt[i] = (bf16_t)(cvt_pk_bf16(pw[(g * 128 + c) * 128 + d], 0.f) & 0xffffu); }
        else { const int k = i - 65536; const int gh = k >> 12, d = (k >> 6) & 63, c = k & 63; gwt[k] = (bf16_t)(cvt_pk_bf16(gw[(gh * 64 + c) * 64 + d], 0.f) & 0xffffu); }
    }
}

__device__ __forceinline__ void norm_phase(const bf16_t* __restrict__ h, const float* __restrict__ xin, bf16_t* XB, float coef, const float* __restrict__ ga, float* __restrict__ RS, float* __restrict__ out) {
    const int tid = ltid(); const int lane = tid & 63, gwv = blockIdx.x * 8 + (tid >> 6), GW = gridDim.x * 8;
    for (int row0 = gwv; row0 < S_; row0 += 2 * GW) {
        const int row1 = (row0 + GW < S_) ? row0 + GW : row0;
        f32x4 xa[8], xb[8];
        if (xin) {
            const f32x4* xr0 = (const f32x4*)(xin + (size_t)row0 * D_); const f32x4* xr1 = (const f32x4*)(xin + (size_t)row1 * D_);
#pragma unroll
            for (int i = 0; i < 8; ++i) { xa[i] = xr0[lane + i * 64]; xb[i] = xr1[lane + i * 64]; }
        } else {
            const u32x2* xr0 = (const u32x2*)(XB + (size_t)row0 * D_); const u32x2* xr1 = (const u32x2*)(XB + (size_t)row1 * D_);
            u32x2 wa[8], wb[8];
#pragma unroll
            for (int i = 0; i < 8; ++i) { wa[i] = xr0[lane + i * 64]; wb[i] = xr1[lane + i * 64]; }
#pragma unroll
            for (int i = 0; i < 8; ++i) {
                xa[i] = (f32x4){__uint_as_float(wa[i].x << 16), __uint_as_float(wa[i].x & 0xffff0000u), __uint_as_float(wa[i].y << 16), __uint_as_float(wa[i].y & 0xffff0000u)};
                xb[i] = (f32x4){__uint_as_float(wb[i].x << 16), __uint_as_float(wb[i].x & 0xffff0000u), __uint_as_float(wb[i].y << 16), __uint_as_float(wb[i].y & 0xffff0000u)}; }
        }
        if (h) {
            u32x2 ha[8], hb[8];
            const u32x2* hr0 = (const u32x2*)(h + (size_t)row0 * D_); const u32x2* hr1 = (const u32x2*)(h + (size_t)row1 * D_);
#pragma unroll
            for (int i = 0; i < 8; ++i) { ha[i] = hr0[lane + i * 64]; hb[i] = hr1[lane + i * 64]; }
            float s0 = 0.f, s1 = 0.f;
#pragma unroll
            for (int i = 0; i < 8; ++i) {
                const float a0 = __uint_as_float(ha[i].x << 16), a1 = __uint_as_float(ha[i].x & 0xffff0000u), a2 = __uint_as_float(ha[i].y << 16), a3 = __uint_as_float(ha[i].y & 0xffff0000u);
                const float b0 = __uint_as_float(hb[i].x << 16), b1 = __uint_as_float(hb[i].x & 0xffff0000u), b2 = __uint_as_float(hb[i].y << 16), b3 = __uint_as_float(hb[i].y & 0xffff0000u);
                s0 += a0 * a0 + a1 * a1 + a2 * a2 + a3 * a3; s1 += b0 * b0 + b1 * b1 + b2 * b2 + b3 * b3; }
            s0 = wave_sum(s0); s1 = wave_sum(s1);
            const float r0 = coef * rsqrtf(s0 * (1.0f / D_) + 1e-6f), r1 = coef * rsqrtf(s1 * (1.0f / D_) + 1e-6f);
#pragma unroll
            for (int i = 0; i < 8; ++i) { const f32x4 g = ((const f32x4*)ga)[lane + i * 64];
                const f32x4 hva = (f32x4){__uint_as_float(ha[i].x << 16), __uint_as_float(ha[i].x & 0xffff0000u), __uint_as_float(ha[i].y << 16), __uint_as_float(ha[i].y & 0xffff0000u)};
                const f32x4 hvb = (f32x4){__uint_as_float(hb[i].x << 16), __uint_as_float(hb[i].x & 0xffff0000u), __uint_as_float(hb[i].y << 16), __uint_as_float(hb[i].y & 0xffff0000u)};
                xa[i] = xa[i] + hva * g * r0; xb[i] = xb[i] + hvb * g * r1; }
        }
        if (out) {
            f32x4* xw0 = (f32x4*)(out + (size_t)row0 * D_); f32x4* xw1 = (f32x4*)(out + (size_t)row1 * D_);
#pragma unroll
            for (int i = 0; i < 8; ++i) { xw0[lane + i * 64] = xa[i]; xw1[lane + i * 64] = xb[i]; }
        } else {
            float s0 = 0.f, s1 = 0.f;
#pragma unroll
            for (int i = 0; i < 8; ++i) { s0 += xa[i][0] * xa[i][0] + xa[i][1] * xa[i][1] + xa[i][2] * xa[i][2] + xa[i][3] * xa[i][3]; s1 += xb[i][0] * xb[i][0] + xb[i][1] * xb[i][1] + xb[i][2] * xb[i][2] + xb[i][3] * xb[i][3]; }
            s0 = wave_sum(s0); s1 = wave_sum(s1);
            if (lane == 0) { RS[row0] = rsqrtf(s0 * (1.0f / D_) + 1e-6f); RS[row1] = rsqrtf(s1 * (1.0f / D_) + 1e-6f); }
            u32x2* xo0 = (u32x2*)(XB + (size_t)row0 * D_); u32x2* xo1 = (u32x2*)(XB + (size_t)row1 * D_);
#pragma unroll
            for (int i = 0; i < 8; ++i) { u32x2 w0, w1; w0.x = cvt_pk_bf16(xa[i][0], xa[i][1]); w0.y = cvt_pk_bf16(xa[i][2], xa[i][3]); w1.x = cvt_pk_bf16(xb[i][0], xb[i][1]); w1.y = cvt_pk_bf16(xb[i][2], xb[i][3]);
                xo0[lane + i * 64] = w0; xo1[lane + i * 64] = w1; }
        }
    }
}

#define MFMA16(a, b, c) __builtin_amdgcn_mfma_f32_16x16x32_bf16((a), (b), (c), 0, 0, 0)

typedef short s16x4 __attribute__((ext_vector_type(4)));
__device__ __forceinline__ void attn_chunk_geom(int ci, int P0, int& kb, int& sh, int& ksel) {
    if (ci < 12) { sh = 0; kb = P0 - 128 + ci * 32; ksel = -1; } else if (ci < 18) { sh = 2; kb = P0 - 512 + ((ci - 12) * 32) * 4; ksel = -1; }
    else { const int k = (ci - 18) / 5, c = (ci - 18) - 5 * k; sh = 4; kb = P0 + 4 * k - 2048 + (c * 32) * 16; ksel = k; }
}
__device__ __forceinline__ void attn_load(const bf16_t* __restrict__ zk, const bf16_t* __restrict__ zv, int kb, int sh, int fr, int lane, bf16x8 (&kq)[4], bf16x8 (&vq)[4]) {
#pragma unroll
    for (int t = 0; t < 2; ++t) { int kp = kb + ((t * 16 + fr) << sh); kp = kp < 0 ? 0 : (kp > S_ - 1 ? S_ - 1 : kp);
        const bf16_t* kr = zk + (size_t)kp * 64; kq[t * 2] = *(const bf16x8*)kr; kq[t * 2 + 1] = *(const bf16x8*)(kr + 32); }
#pragma unroll
    for (int i = 0; i < 4; ++i) { int kp = kb + ((i * 8 + (lane >> 3)) << sh); kp = kp < 0 ? 0 : (kp > S_ - 1 ? S_ - 1 : kp);
        vq[i] = *(const bf16x8*)(zv + (size_t)kp * 64); }
}
__device__ __forceinline__ float xmax_16_32(float v) {
    const unsigned u = __float_as_uint(v);
    const auto r = __builtin_amdgcn_permlane16_swap(u, u, false, false);
    const float w = fmaxf(__uint_as_float(r[0]), __uint_as_float(r[1]));
    const unsigned u2 = __float_as_uint(w);
    const auto r2 = __builtin_amdgcn_permlane32_swap(u2, u2, false, false);
    return fmaxf(__uint_as_float(r2[0]), __uint_as_float(r2[1]));
}
__device__ __forceinline__ void attn_tile(const bf16x8 (&kq)[4], const bf16x8 (&vf)[4], int dbase, int sh, int lim, float nslope2, const bf16x8 qf0, const bf16x8 qf1, float& m, float& l, f32x4 (&o)[4]) {
    f32x4 st[2];
#pragma unroll
    for (int t = 0; t < 2; ++t) { st[t] = MFMA16(kq[t * 2], qf0, ((f32x4){0.f, 0.f, 0.f, 0.f})); st[t] = MFMA16(kq[t * 2 + 1], qf1, st[t]); }
    const float b0 = nslope2 * (float)dbase, bstep = nslope2 * (float)(1 << sh);
    float sv[8]; float cmax = -1e30f;
#pragma unroll
    for (int i = 0; i < 8; ++i) {
        const int c = (i >> 2) * 16 + (i & 3);
        const int delta = dbase - (c << sh);
        const float bias = b0 - bstep * (float)c;
        const float s2 = fmaf(st[i >> 2][i & 3], 0.125f * 1.44269504f, bias);
        sv[i] = ((unsigned)delta <= (unsigned)lim) ? s2 : -1e30f;
        cmax = fmaxf(cmax, sv[i]);
    }
    cmax = xmax_16_32(cmax);
    const float mn = fmaxf(m, cmax), alpha = __builtin_amdgcn_exp2f(m - mn);
    m = mn;
    float ps = 0.f; float pv[8];
#pragma unroll
    for (int i = 0; i < 8; ++i) { pv[i] = __builtin_amdgcn_exp2f(sv[i] - mn); ps += pv[i]; }
    l = l * alpha + ps;
    u32x4 pw; pw.x = cvt_pk_bf16(pv[0], pv[1]); pw.y = cvt_pk_bf16(pv[2], pv[3]); pw.z = cvt_pk_bf16(pv[4], pv[5]); pw.w = cvt_pk_bf16(pv[6], pv[7]);
    const bf16x8 pf = __builtin_bit_cast(bf16x8, pw);
#pragma unroll
    for (int dvt = 0; dvt < 4; ++dvt) { o[dvt] = o[dvt] * alpha; o[dvt] = MFMA16(vf[dvt], pf, o[dvt]); }
}
__device__ __forceinline__ void attn_chunk4(const bf16x8 (&kq)[4], const bf16x8 (&vq)[4], int kb, int sh, int ksel, LAS unsigned char* vst, LAS unsigned char* vrd, const bf16x8 (&qf)[4][2],
                                            int pq0, int fq, float slope, float (&m)[4], float (&l)[4], f32x4 (&o)[4][4]) {
#pragma unroll
    for (int i = 0; i < 4; ++i) *(LAS bf16x8*)(vst + i * 8 * 144) = vq[i];
    bf16x8 vf[4];
#pragma unroll
    for (int dvt = 0; dvt < 4; ++dvt) {
        const s16x4 lo = __builtin_amdgcn_ds_read_tr16_b64_v4i16((LAS s16x4*)(vrd + dvt * 32));
        const s16x4 hi = __builtin_amdgcn_ds_read_tr16_b64_v4i16((LAS s16x4*)(vrd + 16 * 144 + dvt * 32));
        vf[dvt] = (bf16x8){lo[0], lo[1], lo[2], lo[3], hi[0], hi[1], hi[2], hi[3]};
    }
#pragma unroll
    for (int k = 0; k < 4; ++k) if (ksel < 0 || ksel == k) { const int pq = pq0 + 4 * k, wmax = 128 << sh;
        attn_tile(kq, vf, pq - kb - ((fq * 4) << sh), sh, pq < wmax ? pq : wmax, slope, qf[k][0], qf[k][1], m[k], l[k], o[k]); }
}
__device__ __forceinline__ void attn_chunkA(const bf16x8 (&kq)[4], const bf16x8 (&vq)[4], int kb, int c, LAS unsigned char* vst, LAS unsigned char* vrd, const bf16x8 (&qf)[4][2],
                                            int pqA0, int fq, float slope, float (&m)[4], float (&l)[4], f32x4 (&o)[4][4]) {
#pragma unroll
    for (int i = 0; i < 4; ++i) *(LAS bf16x8*)(vst + i * 8 * 144) = vq[i];
    bf16x8 vf[4];
#pragma unroll
    for (int dvt = 0; dvt < 4; ++dvt) {
        const s16x4 lo = __builtin_amdgcn_ds_read_tr16_b64_v4i16((LAS s16x4*)(vrd + dvt * 32));
        const s16x4 hi = __builtin_amdgcn_ds_read_tr16_b64_v4i16((LAS s16x4*)(vrd + 16 * 144 + dvt * 32));
        vf[dvt] = (bf16x8){lo[0], lo[1], lo[2], lo[3], hi[0], hi[1], hi[2], hi[3]};
    }
#pragma unroll
    for (int t = 0; t < 4; ++t) if (c >= 2 * t && c <= 2 * t + 5) { const int pq = pqA0 + 64 * t;
        attn_tile(kq, vf, pq - kb - fq * 4, 0, pq < 128 ? pq : 128, slope, qf[t][0], qf[t][1], m[t], l[t], o[t]); }
}
__device__ __forceinline__ void attn_item(LAS unsigned char* vl, const bf16_t* __restrict__ z, bf16_t* __restrict__ y, int Bblk, int head, int rho, int lane) {
    const int fr = lane & 15, fq = lane >> 4;
    const int P0 = Bblk * 256 + rho, pq0 = P0 + 16 * fr, pqA0 = P0 + 4 * fr;
    const float slope = -1.44269504f * exp2f(-0.5f * (float)(head + 1));
    const bf16_t* zk = z + (size_t)(16 + head) * S_ * 64 + fq * 8;
    const bf16_t* zv = z + (size_t)(32 + head) * S_ * 64 + (lane & 7) * 8;
    LAS unsigned char* vst = vl + (lane >> 3) * 144 + (lane & 7) * 16;
    LAS unsigned char* vrd = vl + (fq * 4 + (fr >> 2)) * 144 + (fr & 3) * 8;
    float m[4], l[4]; f32x4 o[4][4];
#pragma unroll
    for (int k = 0; k < 4; ++k) { m[k] = -1e30f; l[k] = 0.f;
#pragma unroll
        for (int i = 0; i < 4; ++i) o[k][i] = (f32x4){0.f, 0.f, 0.f, 0.f}; }
    bf16x8 k0[4], v0[4], k1[4], v1[4];
    int kb, sh, ks, kbn, shn, ksn;
    {
        const bf16_t* zqA = z + ((size_t)head * S_ + pqA0) * 64 + fq * 8;
        bf16x8 qf[4][2];
#pragma unroll
        for (int t = 0; t < 4; ++t) { qf[t][0] = *(const bf16x8*)(zqA + t * 64 * 64); qf[t][1] = *(const bf16x8*)(zqA + t * 64 * 64 + 32); }
        attn_chunk_geom(0, P0, kb, sh, ks); attn_load(zk, zv, kb, sh, fr, lane, k0, v0);
#pragma unroll 1
        for (int c = 0; c < 12; c += 2) {
            attn_chunk_geom(c + 1, P0, kbn, shn, ksn); attn_load(zk, zv, kbn, shn, fr, lane, k1, v1);
            attn_chunk_geom(c, P0, kb, sh, ks); attn_chunkA(k0, v0, kb, c, vst, vrd, qf, pqA0, fq, slope, m, l, o);
            attn_chunk_geom(c + 2, P0, kbn, shn, ksn); attn_load(zk, zv, kbn, shn, fr, lane, k0, v0);
            attn_chunk_geom(c + 1, P0, kb, sh, ks); attn_chunkA(k1, v1, kb, c + 1, vst, vrd, qf, pqA0, fq, slope, m, l, o);
        }
    }
    {
        LAS float* rec = (LAS float*)vl;
        f32x4 o2[4][4]; float m2[4], l2[4];
        asm volatile("" ::: "memory");
#pragma unroll
        for (int h = 0; h < 2; ++h) {
#pragma unroll
            for (int t = 0; t < 4; ++t) { LAS float* w = rec + ((16 * t + fr) * 4 + fq) * 9;
#pragma unroll
                for (int e = 0; e < 4; ++e) { w[e] = o[t][2 * h][e]; w[4 + e] = o[t][2 * h + 1][e]; }
                w[8] = h ? l[t] : m[t]; }
#pragma unroll
            for (int k = 0; k < 4; ++k) { const LAS float* r = rec + ((16 * (fr >> 2) + (fr & 3) * 4 + k) * 4 + fq) * 9;
#pragma unroll
                for (int e = 0; e < 4; ++e) { o2[k][2 * h][e] = r[e]; o2[k][2 * h + 1][e] = r[4 + e]; }
                if (h) l2[k] = r[8]; else m2[k] = r[8]; }
            asm volatile("" ::: "memory");
        }
#pragma unroll
        for (int k = 0; k < 4; ++k) { m[k] = m2[k]; l[k] = l2[k];
#pragma unroll
            for (int i = 0; i < 4; ++i) o[k][i] = o2[k][i]; }
    }
    {
        const bf16_t* zq = z + ((size_t)head * S_ + pq0) * 64 + fq * 8;
        bf16x8 qf[4][2];
#pragma unroll
        for (int k = 0; k < 4; ++k) { qf[k][0] = *(const bf16x8*)(zq + k * 4 * 64); qf[k][1] = *(const bf16x8*)(zq + k * 4 * 64 + 32); }
#pragma unroll 1
        for (int ci = 12; ci < 38; ci += 2) {
            attn_chunk_geom(ci + 1, P0, kbn, shn, ksn); attn_load(zk, zv, kbn, shn, fr, lane, k1, v1);
            attn_chunk_geom(ci, P0, kb, sh, ks); attn_chunk4(k0, v0, kb, sh, ks, vst, vrd, qf, pq0, fq, slope, m, l, o);
            attn_chunk_geom(ci + 2 < 38 ? ci + 2 : 37, P0, kbn, shn, ksn); attn_load(zk, zv, kbn, shn, fr, lane, k0, v0);
            attn_chunk_geom(ci + 1, P0, kb, sh, ks); attn_chunk4(k1, v1, kb, sh, ks, vst, vrd, qf, pq0, fq, slope, m, l, o);
        }
    }
#pragma unroll
    for (int k = 0; k < 4; ++k) {
        float lk = l[k]; lk += __shfl_xor(lk, 16); lk += __shfl_xor(lk, 32);
        const float inv = 1.0f / lk;
        bf16_t* yo = y + (size_t)(pq0 + 4 * k) * D_ + 1024 + head * 64 + fq * 4;
#pragma unroll
        for (int dvt = 0; dvt < 4; ++dvt) { u32x2 w; w.x = cvt_pk_bf16(o[k][dvt][0] * inv, o[k][dvt][1] * inv); w.y = cvt_pk_bf16(o[k][dvt][2] * inv, o[k][dvt][3] * inv); *(u32x2*)(yo + dvt * 16) = w; }
    }
}

#ifndef POOL_PREF_MAX
#define POOL_PREF_MAX 16
#endif
template <int WIN> __device__ __forceinline__ void pool_load(const bf16_t* __restrict__ zc, int t, bf16x8 (&d)[WIN]) {
#pragma unroll
    for (int j = 0; j < WIN; ++j) { const int tj = t - j; d[j] = *(const bf16x8*)(zc + (size_t)(tj < 0 ? 0 : tj) * INW_); }
}
template <int WIN> __device__ __forceinline__ void pool_item(const bf16_t* __restrict__ z, bf16_t* __restrict__ y, const bf16_t* __restrict__ pwt, const float* __restrict__ scale, int item, int lane) {
    const int fr = lane & 15, fq = lane >> 4;
    constexpr int win = WIN, gi = (WIN == 2) ? 0 : (WIN == 4) ? 1 : (WIN == 8) ? 2 : 3; const int t = item * 16 + fr;
    const float invn = 1.0f / (float)((t + 1) < win ? (t + 1) : win);
    const bf16_t* wb = pwt + (size_t)gi * 16384 + fr * 128 + fq * 8;
    const bf16_t* zb = z + gi * 128 + fq * 8;
    f32x4 acc[8];
#pragma unroll
    for (int dt = 0; dt < 8; ++dt) acc[dt] = (f32x4){0.f, 0.f, 0.f, 0.f};
    constexpr bool PREF = (WIN <= POOL_PREF_MAX);
    bf16x8 zc[WIN], zn[WIN];
    pool_load<WIN>(zb, t, zc);
#pragma unroll 1
    for (int kk = 0; kk < 4; ++kk) {
        bf16x8 wf[8];
#pragma unroll
        for (int dt = 0; dt < 8; ++dt) wf[dt] = *(const bf16x8*)(wb + dt * 16 * 128 + kk * 32);
        if (PREF) pool_load<WIN>(zb + (kk < 3 ? kk + 1 : 3) * 32, t, zn);
        asm volatile("" ::: "memory");
        float s[8];
#pragma unroll
        for (int e = 0; e < 8; ++e) s[e] = 0.f;
#pragma unroll
        for (int j = 0; j < win; ++j) { const float f = (t - j >= 0) ? 1.0f : 0.0f;
#pragma unroll
            for (int e = 0; e < 8; ++e) s[e] += f * bf2f((unsigned short)zc[j][e]); }
        u32x4 w;
        w.x = cvt_pk_bf16(s[0] * invn - bf2f((unsigned short)zc[0][0]), s[1] * invn - bf2f((unsigned short)zc[0][1]));
        w.y = cvt_pk_bf16(s[2] * invn - bf2f((unsigned short)zc[0][2]), s[3] * invn - bf2f((unsigned short)zc[0][3]));
        w.z = cvt_pk_bf16(s[4] * invn - bf2f((unsigned short)zc[0][4]), s[5] * invn - bf2f((unsigned short)zc[0][5]));
        w.w = cvt_pk_bf16(s[6] * invn - bf2f((unsigned short)zc[0][6]), s[7] * invn - bf2f((unsigned short)zc[0][7]));
        const bf16x8 pf = __builtin_bit_cast(bf16x8, w);
#pragma unroll
        for (int dt = 0; dt < 8; ++dt) acc[dt] = MFMA16(wf[dt], pf, acc[dt]);
        if (kk < 3) { if (PREF) {
#pragma unroll
            for (int j = 0; j < WIN; ++j) zc[j] = zn[j]; } else pool_load<WIN>(zb + (kk + 1) * 32, t, zc); }
    }
    bf16_t* yo = y + (size_t)t * D_ + gi * 128 + fq * 4;
    const float* sc = scale + gi * 128 + fq * 4;
    f32x4 s4[8];
#pragma unroll
    for (int dt = 0; dt < 8; ++dt) s4[dt] = *(const f32x4*)(sc + dt * 16);
    asm volatile("" :: "v"(s4[0]), "v"(s4[1]), "v"(s4[2]), "v"(s4[3]), "v"(s4[4]), "v"(s4[5]), "v"(s4[6]), "v"(s4[7]));
#pragma unroll
    for (int dt = 0; dt < 8; ++dt) {
        u32x2 w; w.x = cvt_pk_bf16(acc[dt][0] * s4[dt][0], acc[dt][1] * s4[dt][1]); w.y = cvt_pk_bf16(acc[dt][2] * s4[dt][2], acc[dt][3] * s4[dt][3]);
        *(u32x2*)(yo + dt * 16) = w;
    }
}

__device__ __forceinline__ void lru_item(LAS unsigned char* wlds, const bf16_t* __restrict__ z, const Params& p, int layer, const bf16_t* __restrict__ gwt,
                                         float* __restrict__ HL, float* __restrict__ PC, float* __restrict__ sumP, float* __restrict__ sumH, int item, int lane) {
    const int fr = lane & 15, fq = lane >> 4;
    const int hh = item & 7, ck = item >> 3, T0 = ck * 128;
    const float* convw = p.in[8] + (size_t)layer * 4 * 512 + hh * 64;
    const float* convb = p.in[9] + (size_t)layer * 512 + hh * 64;
    const float* gb = p.in[11] + (size_t)layer * 1024;
    const float* lam = p.in[12] + (size_t)layer * 512 + hh * 64;
    LAS float* Al = (LAS float*)wlds; LAS float* Gl = (LAS float*)(wlds + 4224);
    float br_[4], bi_[4], sp_[4];
#pragma unroll
    for (int nt = 0; nt < 4; ++nt) { const int d = nt * 16 + fr; br_[nt] = gb[hh * 64 + d]; bi_[nt] = gb[512 + hh * 64 + d];
        const float nl = -lam[d]; sp_[nt] = (nl > 20.f) ? nl : log1pf(__expf(nl)); }
    const float w0 = convw[lane], w1 = convw[512 + lane], w2 = convw[1024 + lane], w3 = convw[1536 + lane], cb = convb[lane];
    const bf16_t* zx = z + 512 + hh * 64;
    float xm3 = (T0 >= 3) ? bf2f(zx[(size_t)(T0 - 3) * INW_ + lane]) : 0.f, xm2 = (T0 >= 2) ? bf2f(zx[(size_t)(T0 - 2) * INW_ + lane]) : 0.f, xm1 = (T0 >= 1) ? bf2f(zx[(size_t)(T0 - 1) * INW_ + lane]) : 0.f;
    float hst = 0.f, pst = 1.f;
    bf16x8 gwr[4][2], gwi[4][2];
#pragma unroll
    for (int nt = 0; nt < 4; ++nt)
#pragma unroll
        for (int kk = 0; kk < 2; ++kk) { gwr[nt][kk] = *(const bf16x8*)(gwt + (size_t)(hh * 64 + nt * 16 + fr) * 64 + kk * 32 + fq * 8);
            gwi[nt][kk] = *(const bf16x8*)(gwt + (size_t)((8 + hh) * 64 + nt * 16 + fr) * 64 + kk * 32 + fq * 8); }
    asm volatile("" :: "v"(gwr[0][0]), "v"(gwr[0][1]), "v"(gwr[1][0]), "v"(gwr[1][1]), "v"(gwr[2][0]), "v"(gwr[2][1]), "v"(gwr[3][0]), "v"(gwr[3][1]),
                 "v"(gwi[0][0]), "v"(gwi[0][1]), "v"(gwi[1][0]), "v"(gwi[1][1]), "v"(gwi[2][0]), "v"(gwi[2][1]), "v"(gwi[3][0]), "v"(gwi[3][1]));
    LAS float* wl = (LAS float*)(wlds + 8448);
    wl[lane] = w0; wl[64 + lane] = w1; wl[128 + lane] = w2; wl[192 + lane] = w3; wl[256 + lane] = cb;
    asm volatile("s_waitcnt lgkmcnt(0)" ::: "memory");
    bf16x8 zin[2][4], znx[2][4]; unsigned short xzr[16];
#define LRU_LOAD(ZI, TT0) do { _Pragma("unroll") for (int kk = 0; kk < 2; ++kk) _Pragma("unroll") for (int tap = 0; tap < 4; ++tap) { const int tj = (TT0) + fr - 3 + tap; \
            ZI[kk][tap] = *(const bf16x8*)(zx + (size_t)(tj < 0 ? 0 : tj) * INW_ + kk * 32 + fq * 8); } } while (0)
    LRU_LOAD(zin, T0);
    for (int sub = 0; sub < 8; ++sub) {
        const int t0 = T0 + sub * 16, t = t0 + fr;
#pragma unroll
        for (int tt = 0; tt < 16; ++tt) xzr[tt] = zx[(size_t)(t0 + tt) * INW_ + lane];
        { const int tn = (sub < 7) ? t0 + 16 : t0; LRU_LOAD(znx, tn); }
        bf16x8 xf[2];
#pragma unroll
        for (int kk = 0; kk < 2; ++kk) {
            const int c0 = kk * 32 + fq * 8;
            float a[8];
            { const f32x4 b0 = *(const LAS f32x4*)(wl + 256 + c0), b1 = *(const LAS f32x4*)(wl + 256 + c0 + 4); a[0] = b0[0]; a[1] = b0[1]; a[2] = b0[2]; a[3] = b0[3]; a[4] = b1[0]; a[5] = b1[1]; a[6] = b1[2]; a[7] = b1[3]; }
#pragma unroll
            for (int tap = 0; tap < 4; ++tap) { const float f = (t - 3 + tap >= 0) ? 1.0f : 0.0f;
                const f32x4 wa = *(const LAS f32x4*)(wl + tap * 64 + c0) * f, wb = *(const LAS f32x4*)(wl + tap * 64 + c0 + 4) * f;
                const bf16x8 v = zin[kk][tap];
                a[0] += wa[0] * bf2f((unsigned short)v[0]); a[1] += wa[1] * bf2f((unsigned short)v[1]); a[2] += wa[2] * bf2f((unsigned short)v[2]); a[3] += wa[3] * bf2f((unsigned short)v[3]);
                a[4] += wb[0] * bf2f((unsigned short)v[4]); a[5] += wb[1] * bf2f((unsigned short)v[5]); a[6] += wb[2] * bf2f((unsigned short)v[6]); a[7] += wb[3] * bf2f((unsigned short)v[7]); }
            u32x4 w; w.x = cvt_pk_bf16(a[0], a[1]); w.y = cvt_pk_bf16(a[2], a[3]); w.z = cvt_pk_bf16(a[4], a[5]); w.w = cvt_pk_bf16(a[6], a[7]);
            xf[kk] = __builtin_bit_cast(bf16x8, w);
        }
#pragma unroll
        for (int nt = 0; nt < 4; ++nt) {
            f32x4 ar = (f32x4){0.f, 0.f, 0.f, 0.f}, ai = (f32x4){0.f, 0.f, 0.f, 0.f};
#pragma unroll
            for (int kk = 0; kk < 2; ++kk) {
                ar = MFMA16(xf[kk], gwr[nt][kk], ar); ai = MFMA16(xf[kk], gwi[nt][kk], ai);
            }
#pragma unroll
            for (int j = 0; j < 4; ++j) {
                const float rg = __builtin_amdgcn_rcpf(1.0f + __expf(-(ar[j] + br_[nt]))), ig = __builtin_amdgcn_rcpf(1.0f + __expf(-(ai[j] + bi_[nt])));
                const float la = -8.0f * rg * sp_[nt];
                const float av = __expf(la), gu = sqrtf(fmaxf(1.0f - av * av, 0.f)) * ig;
                Al[(fq * 4 + j) * 66 + nt * 16 + fr] = av; Gl[(fq * 4 + j) * 66 + nt * 16 + fr] = gu;
            }
        }
        asm volatile("s_waitcnt lgkmcnt(0)" ::: "memory");
        float avv[16], guv[16];
#pragma unroll
        for (int tt = 0; tt < 16; ++tt) { avv[tt] = Al[tt * 66 + lane]; guv[tt] = Gl[tt * 66 + lane]; }
        asm volatile("s_waitcnt lgkmcnt(0)" ::: "memory");
#pragma unroll
        for (int tt = 0; tt < 16; ++tt) {
            const float xv = bf2f(xzr[tt]);
            const float xc = cb + w0 * xm3 + w1 * xm2 + w2 * xm1 + w3 * xv;
            xm3 = xm2; xm2 = xm1; xm1 = xv;
            const float av = avv[tt], gu = guv[tt];
            hst = av * hst + gu * xc; pst = pst * av;
            HL[(size_t)(t0 + tt) * 512 + hh * 64 + lane] = hst; PC[(size_t)(t0 + tt) * 512 + hh * 64 + lane] = pst;
        }
        asm volatile("s_waitcnt lgkmcnt(0)" ::: "memory");
#pragma unroll
        for (int kk = 0; kk < 2; ++kk)
#pragma unroll
            for (int tap = 0; tap < 4; ++tap) zin[kk][tap] = znx[kk][tap];
    }
#undef LRU_LOAD
    sumP[(hh * 64 + lane) * 128 + ck] = pst; sumH[(hh * 64 + lane) * 128 + ck] = hst;
}

__device__ __forceinline__ void mixers_phase(LAS unsigned char* lds, const Params& p, int layer) {
    const bf16_t* z = (const bf16_t*)(p.ws + OFF_HID); bf16_t* y = (bf16_t*)(p.ws + OFF_Y);
    float* HL = (float*)(p.ws + OFF_H); float* PC = HL + (size_t)S_ * 512;
    float* sumP = (float*)(p.ws + OFF_LSUM); float* sumH = sumP + 128 * 512;
    const int tid = ltid(); const int lane = tid & 63;
    const int wid = __builtin_amdgcn_readfirstlane(tid >> 6);
    const int gwv = blockIdx.x * 8 + wid, GW = gridDim.x * 8;
    const bf16_t* pwt = (const bf16_t*)(p.ws + OFF_POOLW); const float* psc = p.in[7] + (size_t)layer * 512;
    const int G = gridDim.x;
#ifdef PROBE_PH_A
#define E1_STAMP(K) do { if (blockIdx.x == 0 && tid == 0 && layer == 0) __hip_atomic_store((unsigned long long*)(p.ws + OFF_TS) + 40 + (K), (unsigned long long)__builtin_amdgcn_s_memrealtime(), __ATOMIC_RELAXED, __HIP_MEMORY_SCOPE_AGENT); } while (0)
#else
#define E1_STAMP(K) do {} while (0)
#endif
    E1_STAMP(0);
    for (int i = blockIdx.x * 4 + wid; i < 1024; i += G * 4) {
        if (wid < 4) lru_item(lds + wid * 16384, z, p, layer, (const bf16_t*)(p.ws + OFF_GATEW), HL, PC, sumP, sumH, i, lane);
#ifdef DUP_LRU
        if (wid < 4) lru_item(lds + wid * 16384, z, p, layer, (const bf16_t*)(p.ws + OFF_GATEW), HL, PC, sumP, sumH, i, lane);
#endif
    }
    E1_STAMP(1);
    if ((G & 7) == 0) {
        const int xcd = blockIdx.x & 7, lw = (blockIdx.x >> 3) * 8 + wid, nlw = (G >> 3) * 8;
        for (int j = lw; j < 512; j += nlw) { const int head = xcd * 2 + ((j >> 2) & 1);
            attn_item(lds + wid * 16384, (const bf16_t*)(p.ws + OFF_QKV), y, j >> 3, head, j & 3, lane);
#ifdef DUP_ATT
            attn_item(lds + wid * 16384, (const bf16_t*)(p.ws + OFF_QKV), y, j >> 3, head, j & 3, lane);
#endif
        }
    } else {
        for (int i = gwv; i < 4096; i += GW) attn_item(lds + wid * 16384, (const bf16_t*)(p.ws + OFF_QKV), y, i >> 6, (i >> 2) & 15, i & 3, lane);
    }
    E1_STAMP(2);
    if (wid >= 4) {
        for (int i = blockIdx.x * 4 + (wid - 4), k = 0; i < 4096; i += G * 4, ++k) { const int tt = i >> 2;
            switch ((k & 1) ? 3 - (i & 3) : (i & 3)) { case 0: pool_item<2>(z, y, pwt, psc, tt, lane); break; case 1: pool_item<4>(z, y, pwt, psc, tt, lane); break; case 2: pool_item<8>(z, y, pwt, psc, tt, lane); break; default: pool_item<16>(z, y, pwt, psc, tt, lane); break; }
        }
    }
    E1_STAMP(3);
}

__device__ __forceinline__ void lru_final_phase(const Params& p) {
    const bf16_t* z = (const bf16_t*)(p.ws + OFF_HID); bf16_t* y = (bf16_t*)(p.ws + OFF_Y);
    const float* HL = (const float*)(p.ws + OFF_H); const float* PC = HL + (size_t)S_ * 512;
    const float* sumP = (const float*)(p.ws + OFF_LSUM); const float* sumH = sumP + 128 * 512;
    const int d = ltid();
    for (int it = blockIdx.x; it < 256; it += gridDim.x) {
        const int ck = it >> 1, t0 = it * 64;
        float hl[16], pc[16]; unsigned short gz[16];
#define E2_LOAD(TB) do { _Pragma("unroll") for (int k = 0; k < 16; ++k) { const size_t t = (size_t)(t0 + (TB) + k); hl[k] = HL[t * 512 + d]; pc[k] = PC[t * 512 + d]; gz[k] = z[t * INW_ + 1024 + d]; } } while (0)
        E2_LOAD(0);
        float carry = 0.f;
        for (int c0 = 0; c0 < ck; c0 += 64) {
            f32x4 pp[16], hq[16];
            const f32x4* sp4 = (const f32x4*)(sumP + (size_t)d * 128 + c0); const f32x4* sh4 = (const f32x4*)(sumH + (size_t)d * 128 + c0);
#pragma unroll
            for (int k = 0; k < 16; ++k) { pp[k] = sp4[k]; hq[k] = sh4[k]; }
            asm volatile("" :: "v"(pp[0]), "v"(pp[1]), "v"(pp[2]), "v"(pp[3]), "v"(pp[4]), "v"(pp[5]), "v"(pp[6]), "v"(pp[7]), "v"(pp[8]), "v"(pp[9]), "v"(pp[10]), "v"(pp[11]), "v"(pp[12]), "v"(pp[13]), "v"(pp[14]), "v"(pp[15]));
            asm volatile("" :: "v"(hq[0]), "v"(hq[1]), "v"(hq[2]), "v"(hq[3]), "v"(hq[4]), "v"(hq[5]), "v"(hq[6]), "v"(hq[7]), "v"(hq[8]), "v"(hq[9]), "v"(hq[10]), "v"(hq[11]), "v"(hq[12]), "v"(hq[13]), "v"(hq[14]), "v"(hq[15]));
#pragma unroll
            for (int k = 0; k < 16; ++k)
#pragma unroll
                for (int e = 0; e < 4; ++e) { const bool in = (c0 + k * 4 + e) < ck; carry = in ? pp[k][e] * carry + hq[k][e] : carry; }
        }
#pragma unroll 1
        for (int tb = 0; tb < 64; tb += 16) {
            if (tb) E2_LOAD(tb);
            __builtin_amdgcn_sched_barrier(0);
#pragma unroll
            for (int k = 0; k < 16; ++k) { const size_t t = (size_t)(t0 + tb + k);
                const float hv = hl[k] + pc[k] * carry;
                const float g = bf2f(gz[k]);
                const float u = 0.7978845608f * (g + 0.044715f * g * g * g);
                const float th = 1.0f - 2.0f * __builtin_amdgcn_rcpf(1.0f + __expf(2.0f * u));
                const float ge = 0.5f * g * (1.0f + th);
                y[t * D_ + 512 + d] = (bf16_t)(cvt_pk_bf16(hv * ge, 0.f) & 0xffffu); }
        }
#undef E2_LOAD
    }
}

__global__ void __launch_bounds__(512, 2) mk_fwd(Params p, int ph_lo, int ph_hi) {
    extern __shared__ __attribute__((aligned(16))) unsigned char shm[];
    LAS unsigned char* lds = (LAS unsigned char*)shm;
    cg::grid_group grid = cg::this_grid();
    unsigned char* ws = p.ws;
    volatile LAS unsigned* bst = (volatile LAS unsigned*)(lds + 131072);
    if (threadIdx.x < 4) bst[threadIdx.x] = 0u;
    __syncthreads();
    if (ph_hi - ph_lo > 1) {
        if (blockIdx.x == 0) { for (int i = threadIdx.x; i < XCD_BAR_WORDS; i += 512) __hip_atomic_store((unsigned*)(ws + OFF_BAR) + i, 0u, __ATOMIC_RELAXED, __HIP_MEMORY_SCOPE_AGENT); }
        grid.sync();
    }
    XcdBarrier bar = xcd_barrier_post((unsigned*)(ws + OFF_BAR), bst);
#ifdef PROBE_PH_A
    if (blockIdx.x == 0 && threadIdx.x == 0) __hip_atomic_store((unsigned long long*)(ws + OFF_TS), (unsigned long long)__builtin_amdgcn_s_memrealtime(), __ATOMIC_RELAXED, __HIP_MEMORY_SCOPE_AGENT);
#endif
    bf16_t* XN = (bf16_t*)(ws + OFF_XN); float* RS = (float*)(ws + OFF_RS);        bf16_t* HID = (bf16_t*)(ws + OFF_HID); bf16_t* H = (bf16_t*)(ws + OFF_H); bf16_t* Y = (bf16_t*)(ws + OFF_Y);
    for (int ph = ph_lo; ph < ph_hi; ++ph) {
#ifdef DUP_MASK
      for (int rep = 0; rep < ((ph > 0 && ((DUP_MASK >> ((ph - 1) % 11)) & 1)) ? 2 : 1); ++rep)
#endif
        if (ph == 0) {
            convert_phase(lds, p, 0);
#ifdef DUP_CONV
            convert_phase(lds, p, 0); convert_phase(lds, p, 0);
#endif
            norm_phase(nullptr, p.in[0], XN, 0.f, nullptr, RS, nullptr);
        } else {
            const int layer = (ph - 1) / 11, st = (ph - 1) % 11;
            const float* g = p.in[1] + (size_t)layer * 6 * D_;
            if (st == 0 || st == 8) {
                pg8::Gemm gm; gm.A = XN; gm.Bt = (const bf16_t*)(ws + (st == 0 ? OFF_W1IN : OFF_W2IN)); gm.M = S_; gm.N = 2 * DFF_; gm.K = D_;
                pg8::StaticOrder so; so.init(gm.M, gm.N, (int)gridDim.x, (int)blockIdx.x);
                pg8::EpiSwiGLU e; e.O = HID; e.ldc = DFF_; e.RS = RS;
                #ifndef NO_G1
                pg8::gemm_phase<pg8::EpiSwiGLU, pg8::StaticOrder, true, true>(lds, gm, so, e);
#endif
            } else if (st == 1 || st == 9 || st == 6 || st == 3) {
                pg8::Gemm gm; gm.M = S_; pg8::EpiBf16P e;
                e.QKV = nullptr; e.RS = nullptr;
                if (st == 3) { gm.A = XN; gm.Bt = (const bf16_t*)(ws + OFF_WMIN); gm.N = INW_; gm.K = D_; e.O = HID; e.ldc = INW_; e.QKV = (bf16_t*)(ws + OFF_QKV); e.RS = RS; }
                else if (st == 6) { gm.A = Y; gm.Bt = (const bf16_t*)(ws + OFF_WMOUT); gm.N = D_; gm.K = D_; e.O = H; e.ldc = D_; }
                else { gm.A = HID; gm.Bt = (const bf16_t*)(ws + (st == 1 ? OFF_W1OUT : OFF_W2OUT)); gm.N = D_; gm.K = DFF_; e.O = H; e.ldc = D_; }
                pg8::StaticOrder so; so.init(gm.M, gm.N, (int)gridDim.x, (int)blockIdx.x);
                pg8::gemm_phase<pg8::EpiBf16P, pg8::StaticOrder, true, true>(lds, gm, so, e);
            } else if (st == 2) {
                norm_phase(H, nullptr, XN, 0.5f, g + 1 * D_, RS, nullptr);
            } else if (st == 7) {
                norm_phase(H, nullptr, XN, 1.0f, g + 3 * D_, RS, nullptr);
            } else if (st == 10) {
                const bool more = (layer + 1 < DEPTH_);
                norm_phase(H, nullptr, XN, 0.5f, g + 5 * D_, RS, more ? nullptr : p.out);
                if (more) convert_phase(lds, p, layer + 1);
            } else if (st == 4) {
#ifndef NO_MIX
                mixers_phase(lds, p, layer);
#endif
            } else {
                lru_final_phase(p);
            }
        }
        if (ph + 1 < ph_hi) xcd_barrier(bar);
#ifdef PROBE_PH_A
        if (ph + 1 == ph_hi) xcd_barrier(bar);
        if (blockIdx.x == 0 && threadIdx.x == 0) __hip_atomic_store((unsigned long long*)(ws + OFF_TS) + ph + 1, (unsigned long long)__builtin_amdgcn_s_memrealtime(), __ATOMIC_RELAXED, __HIP_MEMORY_SCOPE_AGENT);
#endif
    }
#ifdef PROBE_PH_A
    {
        xcd_barrier(bar);
        const unsigned long long* ts = (const unsigned long long*)(ws + OFF_TS);
        const unsigned long long a0 = __hip_atomic_load(ts + PROBE_PH_A, __ATOMIC_RELAXED, __HIP_MEMORY_SCOPE_AGENT), a1 = __hip_atomic_load(ts + PROBE_PH_A + 1, __ATOMIC_RELAXED, __HIP_MEMORY_SCOPE_AGENT);
        const unsigned long long b0 = __hip_atomic_load(ts + PROBE_PH_B, __ATOMIC_RELAXED, __HIP_MEMORY_SCOPE_AGENT), b1 = __hip_atomic_load(ts + PROBE_PH_B + 1, __ATOMIC_RELAXED, __HIP_MEMORY_SCOPE_AGENT);
#ifdef PROBE_CONST
        const float dA = PROBE_CONST;
#else
#ifdef PROBE_SPAN
        const unsigned long long e1 = __hip_atomic_load(ts + PROBE_PH_A + PROBE_SPAN, __ATOMIC_RELAXED, __HIP_MEMORY_SCOPE_AGENT);
        const float dA = (float)(e1 - a0) * 0.01f * 1e-6f;
#else
        const float dA = (float)(a1 - a0) * 0.01f * 1e-5f;
#endif
#endif
        const float dB = 0.1f + (float)(b1 - b0) * 0.01f * (1.0f / 2000.0f);
        for (size_t i = (size_t)blockIdx.x * 512 + threadIdx.x; i < (size_t)S_ * D_; i += (size_t)gridDim.x * 512) p.out[i] += dA + (i == 777 ? dB : 0.f);
    }
#endif
}

#ifndef MK_COOP
#define MK_COOP 1
#endif
extern "C" void kernel_launch(void* const* d_in, const int* in_sizes, int n_in, void* d_out, int out_size, void* d_ws, size_t ws_size, hipStream_t stream) {
    static int grid_blocks = 0;
    if (!grid_blocks) {
        if (n_in != 15 || out_size != S_ * D_ || ws_size < WS_END) { fprintf(stderr, "kernel_launch: unexpected shapes (n_in %d out %d ws %zu need %zu)\n", n_in, out_size, ws_size, (size_t)WS_END); grid_blocks = -1; return; }
        int dev = 0, cus = 0, per_cu = 0;
        hipGetDevice(&dev);
        hipDeviceGetAttribute(&cus, hipDeviceAttributeMultiprocessorCount, dev);
        if (hipFuncSetAttribute((const void*)mk_fwd, hipFuncAttributeMaxDynamicSharedMemorySize, LDS_BYTES) != hipSuccess) { fprintf(stderr, "kernel_launch: hipFuncSetAttribute failed\n"); grid_blocks = -1; return; }
        hipOccupancyMaxActiveBlocksPerMultiprocessor(&per_cu, (const void*)mk_fwd, 512, LDS_BYTES);
        if (per_cu < 1) { fprintf(stderr, "kernel_launch: occupancy query says %d\n", per_cu); per_cu = 1; }
        (void)hipGetLastError();
        grid_blocks = cus * per_cu;
    }
    if (grid_blocks < 0) return;
    Params p{};
    for (int i = 0; i < 15; ++i) p.in[i] = (const float*)d_in[i];
    p.out = (float*)d_out; p.ws = (unsigned char*)d_ws;
#if MK_COOP
    int lo = 0, hi = NPHASE;
    void* args[] = {&p, &lo, &hi};
    hipError_t e = hipLaunchCooperativeKernel((const void*)mk_fwd, dim3(grid_blocks), dim3(512), args, LDS_BYTES, stream);
    if (e != hipSuccess) fprintf(stderr, "cooperative launch failed: %s (grid %d)\n", hipGetErrorString(e), grid_blocks);
#else
    for (int ph = 0; ph < NPHASE; ++ph) hipLaunchKernelGGL(mk_fwd, dim3(grid_blocks), dim3(512), LDS_BYTES, stream, p, ph, ph + 1);
#endif
}
```

```cpp
#include <hip/hip_runtime.h>
#include <hip/hip_cooperative_groups.h>
#include <cstdio>
namespace cg = cooperative_groups;
#define XB_TMO      128
#define XB_XCNT(j)  (256  + 64 * (j))
#define XB_XSUB(j)  (1280 + 64 * (j))
#define XB_XGEN(j)  (2304 + 64 * (j))
#define XB_TOP      3328
#define XB_TOPGEN   3392
#define XCD_BAR_WORDS 3456
#define XB_SPIN_CAP (1u << 18)
#define LAS __attribute__((address_space(3)))

__device__ __forceinline__ unsigned xb_ld(unsigned* p)              { return __hip_atomic_load(p, __ATOMIC_RELAXED, __HIP_MEMORY_SCOPE_AGENT); }
__device__ __forceinline__ unsigned xb_add(unsigned* p, unsigned v) { return __hip_atomic_fetch_add(p, v, __ATOMIC_RELAXED, __HIP_MEMORY_SCOPE_AGENT); }
__device__ __forceinline__ unsigned xb_xcc_id() { return (unsigned)__builtin_amdgcn_s_getreg((3 << 11) | 20) & 0xFu; }
#define XB_SPIN(cond, bar) do { unsigned _sp = 0; while (cond) { __builtin_amdgcn_s_sleep(1); \
    if ((++_sp & 255u) == 0u) { if (xb_ld(&(bar)[XB_TMO])) break; if (_sp > XB_SPIN_CAP) { atomicAdd(&(bar)[XB_TMO], 1u); break; } } } } while (0)

struct XcdBarrier {
    unsigned* bar; unsigned x;
    volatile LAS unsigned* st;
};

__device__ __forceinline__ XcdBarrier xcd_barrier_post(unsigned* bar, volatile LAS unsigned* st) {
    XcdBarrier b; b.bar = bar; b.x = xb_xcc_id(); b.st = st;
    if (threadIdx.x == 0) (void)xb_add(&bar[XB_XCNT(b.x)], 1u);
    return b;
}
__device__ __forceinline__ void xcd_barrier_complete(unsigned* bar, unsigned x, unsigned& nloc, unsigned& nx) {
    const unsigned G = gridDim.x * gridDim.y * gridDim.z;
    unsigned sum, cnt, mine, sp = 0u;
    for (;;) {
        sum = 0u; cnt = 0u; mine = 0u;
#pragma unroll
        for (unsigned j = 0; j < 16; ++j) { const unsigned c = xb_ld(&bar[XB_XCNT(j)]); sum += c; cnt += (c > 0u) ? 1u : 0u; mine = (j == x) ? c : mine; }
        if (sum == G) break;
        __builtin_amdgcn_s_sleep(1);
        if ((++sp & 255u) == 0u) { if (xb_ld(&bar[XB_TMO])) break; if (sp > XB_SPIN_CAP) { atomicAdd(&bar[XB_TMO], 1u); break; } }
    }
    nloc = mine > 0u ? mine : 1u; nx = cnt > 0u ? cnt : 1u;
}

__device__ __forceinline__ void xcd_barrier(const XcdBarrier& b) {
    asm volatile("s_waitcnt vmcnt(0)" ::: "memory");
    __syncthreads();
    if (threadIdx.x == 0) {
        unsigned* bar = b.bar;
        __builtin_amdgcn_s_waitcnt(0);
        unsigned nloc = b.st[0], nx = b.st[1];
        if (nloc == 0u) { xcd_barrier_complete(bar, b.x, nloc, nx); b.st[0] = nloc; b.st[1] = nx; }
        const unsigned old = xb_add(&bar[XB_XSUB(b.x)], 1u);
        const unsigned gen = old / nloc;
        if (old + 1u == (gen + 1u) * nloc) {
            __builtin_amdgcn_fence(__ATOMIC_RELEASE, "agent");
            asm volatile("s_waitcnt vmcnt(0)" ::: "memory");
            const unsigned og = xb_add(&bar[XB_TOP], 1u);
            const unsigned tg = og / nx;
            if (og + 1u == (tg + 1u) * nx) xb_add(&bar[XB_TOPGEN], 1u);
            else XB_SPIN(xb_ld(&bar[XB_TOPGEN]) == tg, bar);
            __builtin_amdgcn_fence(__ATOMIC_ACQUIRE, "agent");
            xb_add(&bar[XB_XGEN(b.x)], 1u);
            asm volatile("s_waitcnt vmcnt(0)" ::: "memory");
        } else {
            XB_SPIN(xb_ld(&bar[XB_XGEN(b.x)]) == gen, bar);
            __builtin_amdgcn_fence(__ATOMIC_ACQUIRE, "agent");
            asm volatile("s_waitcnt vmcnt(0)" ::: "memory");
        }
    }
    __syncthreads();
}
#include <hip/hip_runtime.h>
namespace pg8 {
#define PG8_LAS __attribute__((address_space(3)))
typedef unsigned short bf16_t;
typedef short bf16x8 __attribute__((ext_vector_type(8)));
typedef float f32x4 __attribute__((ext_vector_type(4)));
typedef unsigned u32x4 __attribute__((ext_vector_type(4)));
constexpr int BM = 256, BK = 64, HALF = 128, HTB = HALF * BK * 2  , STAGE_BYTES = 8 * HTB, NXCD = 8, WGM = 8;

__host__ __device__ __forceinline__ int lds_byte(int r, int c) { const int st = (r >> 4) * 2 + (c >> 5), rr = r & 15, cc = c & 31, ob = rr * 64 + cc * 2; return st * 1024 + (ob ^ (((ob >> 9) & 1) << 5)); }
__host__ __device__ __forceinline__ void stage_rc(int b, int& R, int& C) { const int st = b / 1024, sb = b % 1024, swz = sb ^ (((sb >> 9) & 1) << 5); R = (st >> 1) * 16 + swz / 64; C = (st & 1) * 32 + (swz % 64) / 2; }
__host__ __device__ __forceinline__ int perm32(int rho) { const int n = rho >> 4, i = rho & 15; return 8 * (i >> 2) + 4 * n + (i & 3); }

struct Unit { int pm, pn; };
struct Gemm { const bf16_t* A; const bf16_t* Bt; int M, N, K; };

struct StaticOrder {
    int nM, nN, nwg, G, c, i0, rounds;
    __host__ __device__ void init(int M, int N, int G_, int c_) { nM = M / BM; nN = N / BM; nwg = nM * nN; G = G_; c = c_; i0 = 0; rounds = 1 << 30; }
    __host__ __device__ bool next(int i, Unit& u) const {
        if (i >= rounds) return false;
        const long L = (long)(i + i0) * G + c; if (L >= nwg) return false;
        int wgid = (int)L; { const int q = nwg / NXCD, r = nwg % NXCD, xcd = wgid % NXCD, off = wgid / NXCD; wgid = (xcd < r ? xcd * (q + 1) : r * (q + 1) + (xcd - r) * q) + off; }
        const int nig = WGM * nN, gid = wgid / nig, fm = gid * WGM, gsz = (nM - fm) < WGM ? (nM - fm) : WGM;
        u.pm = fm + ((wgid % nig) % gsz); u.pn = (wgid % nig) / gsz; return true;
    }
    __device__ __forceinline__ void a_ready(const Unit&) const {}
    __device__ __forceinline__ void done(const Unit&) const {}
};
__device__ __forceinline__ unsigned cvt_pk_bf16(float lo, float hi) { unsigned r; asm volatile("v_cvt_pk_bf16_f32 %0, %1, %2" : "=v"(r) : "v"(lo), "v"(hi)); return r; }
struct EpiF32 {
    static constexpr bool PERM = false, AFTER_DRAIN = false;
    float* C; int ldc; const float* bias;
    __device__ __forceinline__ void operator()(const f32x4 (&acc)[2][2][4][2], const Unit& u, int wr, int wc, int fr, int fq) const {
        const int row0 = u.pm * BM + wr * 64 + fr, col0 = u.pn * BM + wc * 32 + 4 * fq;
        f32x4 bv[2][2];
#pragma unroll
        for (int bj = 0; bj < 2; ++bj)
#pragma unroll
            for (int n = 0; n < 2; ++n) bv[bj][n] = bias ? *(const f32x4*)(bias + col0 + bj * HALF + n * 16) : (f32x4){0.f, 0.f, 0.f, 0.f};
#pragma unroll
        for (int ai = 0; ai < 2; ++ai)
#pragma unroll
            for (int m = 0; m < 4; ++m) { float* rowp = C + (size_t)(row0 + ai * HALF + m * 16) * ldc + col0;
#pragma unroll
                for (int bj = 0; bj < 2; ++bj)
#pragma unroll
                    for (int n = 0; n < 2; ++n) *(f32x4*)(rowp + bj * HALF + n * 16) = acc[ai][bj][m][n] + bv[bj][n]; }
    }
};
typedef unsigned u32x2 __attribute__((ext_vector_type(2)));
struct EpiBf16P {
    static constexpr bool PERM = true, AFTER_DRAIN = false;
    bf16_t* O; int ldc; bf16_t* QKV; const float* RS;
    __device__ __forceinline__ void operator()(const f32x4 (&acc)[2][2][4][2], const Unit& u, int wr, int wc, int fr, int fq) const {
        const int row0 = u.pm * BM + wr * 64 + fr, col0 = u.pn * BM + wc * 32 + 8 * fq;
        const bool redir = (QKV != nullptr) && (u.pn >= 6);
        const int hd0 = (((u.pn - 6) >> 2) * 16 + ((u.pn - 6) & 3) * 4 + (wc >> 1));
        float rsv[8];
#pragma unroll
        for (int q = 0; q < 8; ++q) rsv[q] = RS ? RS[row0 + (q >> 2) * HALF + (q & 3) * 16] : 1.0f;
        if (RS) asm volatile("" :: "v"(rsv[0]), "v"(rsv[1]), "v"(rsv[2]), "v"(rsv[3]), "v"(rsv[4]), "v"(rsv[5]), "v"(rsv[6]), "v"(rsv[7]));
#pragma unroll
        for (int ai = 0; ai < 2; ++ai)
#pragma unroll
            for (int m = 0; m < 4; ++m) { const int row = row0 + ai * HALF + m * 16; const float rsc = rsv[ai * 4 + m];
                bf16_t* rowp = redir ? QKV + ((size_t)hd0 * 16384 + row) * 64 + (wc & 1) * 32 + 8 * fq : O + (size_t)row * ldc + col0;
                const size_t bjstep = redir ? (size_t)2 * 16384 * 64 : (size_t)HALF;
#pragma unroll
                for (int bj = 0; bj < 2; ++bj) { const f32x4 v0 = acc[ai][bj][m][0] * rsc, v1 = acc[ai][bj][m][1] * rsc;
                    u32x4 w; w.x = cvt_pk_bf16(v0[0], v0[1]); w.y = cvt_pk_bf16(v0[2], v0[3]); w.z = cvt_pk_bf16(v1[0], v1[1]); w.w = cvt_pk_bf16(v1[2], v1[3]);
                    *(u32x4*)(rowp + bj * bjstep) = w; } }
    }
};
__device__ __forceinline__ float silu_mul(float g, float u) { return g * u * __builtin_amdgcn_rcpf(1.0f + __expf(-g)); }
struct EpiSwiGLU {
    static constexpr bool PERM = true, AFTER_DRAIN = false;
    bf16_t* O; int ldc; const float* RS;
    __device__ __forceinline__ void operator()(const f32x4 (&acc)[2][2][4][2], const Unit& u, int wr, int wc, int fr, int fq) const {
        const int row0 = u.pm * BM + wr * 64 + fr, col0 = u.pn * HALF + wc * 32 + 8 * fq;
        float rsv[8];
#pragma unroll
        for (int q = 0; q < 8; ++q) rsv[q] = RS[row0 + (q >> 2) * HALF + (q & 3) * 16];
        asm volatile("" :: "v"(rsv[0]), "v"(rsv[1]), "v"(rsv[2]), "v"(rsv[3]), "v"(rsv[4]), "v"(rsv[5]), "v"(rsv[6]), "v"(rsv[7]));
#pragma unroll
        for (int ai = 0; ai < 2; ++ai)
#pragma unroll
            for (int m = 0; m < 4; ++m) { bf16_t* rowp = O + (size_t)(row0 + ai * HALF + m * 16) * ldc + col0; const float rsc = rsv[ai * 4 + m];
                const f32x4 g0 = acc[ai][0][m][0] * rsc, g1 = acc[ai][0][m][1] * rsc, u0 = acc[ai][1][m][0] * rsc, u1 = acc[ai][1][m][1] * rsc;
                u32x4 w; w.x = cvt_pk_bf16(silu_mul(g0[0], u0[0]), silu_mul(g0[1], u0[1])); w.y = cvt_pk_bf16(silu_mul(g0[2], u0[2]), silu_mul(g0[3], u0[3]));
                w.z = cvt_pk_bf16(silu_mul(g1[0], u1[0]), silu_mul(g1[1], u1[1])); w.w = cvt_pk_bf16(silu_mul(g1[2], u1[2]), silu_mul(g1[3], u1[3]));
                *(u32x4*)rowp = w; }
    }
};

template <class Epi, class Sched, bool ALIGN_EPI = false, bool SP2 = false>
__device__ __forceinline__ void gemm_phase(PG8_LAS unsigned char* lds, const Gemm g, const Sched& S, const Epi& E) {
    int tid_l = threadIdx.x; asm volatile("" : "+v"(tid_l));
    const int tid = tid_l, wid = __builtin_amdgcn_readfirstlane(tid >> 6), lane = tid & 63, wr = wid >> 2, wc = wid & 3, fr = lane & 15, fq = lane >> 4;
    const int K = g.K, nt = K / BK;
    unsigned voffA[2], voffB[2];
#pragma unroll
    for (int i = 0; i < 2; ++i) { int R, C; stage_rc(tid * 16 + i * 8192, R, C); const int Rb = Epi::PERM ? ((R & ~31) + perm32(R & 31)) : R;
        voffA[i] = (unsigned)(R * K + C) * 2u; voffB[i] = (unsigned)(Rb * K + C) * 2u; }
    const size_t kstep = (size_t)(BK * 2);
    const size_t hstep = (size_t)HALF * K * 2;
    const size_t tstep = 2 * hstep;
    const unsigned ldsw = (unsigned)wid * 1024u;
    const int aoff = lds_byte(wr * 64 + fr, fq * 8), boff = lds_byte(wc * 32 + fr, fq * 8);
#define PG8_SA(b, h) (((b) * 2 + (h)) * HTB)
#define PG8_SB(b, h) ((4 + (b) * 2 + (h)) * HTB)
#define PG8_STAGE(bufoff, gbase, voff) do { _Pragma("unroll") for (int _i = 0; _i < 2; ++_i) \
        __builtin_amdgcn_global_load_lds((const unsigned*)((const char*)(gbase) + (voff)[_i]), (PG8_LAS unsigned*)(lds + (bufoff) + ldsw + _i * 8192), 16, 0, 0); } while (0)
#define PG8_LDA(dst, b, h) do { _Pragma("unroll") for (int m = 0; m < 4; ++m) _Pragma("unroll") for (int k = 0; k < 2; ++k) dst[m][k] = *(const PG8_LAS bf16x8*)(lds + PG8_SA(b, h) + aoff + m * 2048 + k * 1024); } while (0)
#define PG8_LDB(dst, b, h) do { _Pragma("unroll") for (int n = 0; n < 2; ++n) _Pragma("unroll") for (int k = 0; k < 2; ++k) dst[n][k] = *(const PG8_LAS bf16x8*)(lds + PG8_SB(b, h) + boff + n * 2048 + k * 1024); } while (0)
#define PG8_MMA(ai, bj, At, Bt) do { __builtin_amdgcn_s_setprio(1); _Pragma("unroll") for (int m = 0; m < 4; ++m) _Pragma("unroll") for (int n = 0; n < 2; ++n) _Pragma("unroll") for (int k = 0; k < 2; ++k) \
        acc[ai][bj][m][n] = __builtin_amdgcn_mfma_f32_16x16x32_bf16(Bt[n][k], At[m][k], acc[ai][bj][m][n], 0, 0, 0); __builtin_amdgcn_s_setprio(0); } while (0)
#define PG8_WAIT_V(n) asm volatile("s_waitcnt vmcnt(" #n ")" ::: "memory")
#define PG8_WAIT_L(n) asm volatile("s_waitcnt lgkmcnt(" #n ")" ::: "memory")
#define PG8_BAR __builtin_amdgcn_s_barrier()
#define PG8_SCHED __builtin_amdgcn_sched_barrier(0)
    Unit cur, nxt; int ui = 0;
    if (!S.next(0, cur)) return;
    f32x4 acc[2][2][4][2];
#pragma unroll
    for (int a = 0; a < 2; ++a)
#pragma unroll
        for (int b = 0; b < 2; ++b)
#pragma unroll
            for (int m = 0; m < 4; ++m)
#pragma unroll
                for (int n = 0; n < 2; ++n) acc[a][b][m][n] = (f32x4){0.f, 0.f, 0.f, 0.f};
    bf16x8 At[4][2], B0[2][2], B1[2][2];
    const char* cA = (const char*)g.A + (size_t)cur.pm * tstep; const char* cB = (const char*)g.Bt + (size_t)cur.pn * tstep;
    S.a_ready(cur);
    if constexpr (SP2) {
        PG8_STAGE(PG8_SB(0, 0), cB, voffB); PG8_STAGE(PG8_SB(0, 1), cB + hstep, voffB); PG8_STAGE(PG8_SA(0, 0), cA, voffA); PG8_STAGE(PG8_SA(0, 1), cA + hstep, voffA);
        if (wr == 1) PG8_BAR;
        PG8_WAIT_V(2); PG8_BAR;
        PG8_STAGE(PG8_SB(1, 0), cB + kstep, voffB); PG8_STAGE(PG8_SA(1, 0), cA + kstep, voffA); PG8_STAGE(PG8_SB(1, 1), cB + hstep + kstep, voffB);
        PG8_WAIT_V(6); PG8_BAR;
    } else {
        PG8_STAGE(PG8_SB(0, 0), cB, voffB); PG8_STAGE(PG8_SA(0, 0), cA, voffA); PG8_STAGE(PG8_SB(0, 1), cB + hstep, voffB); PG8_STAGE(PG8_SA(0, 1), cA + hstep, voffA);
        if (wr == 1) PG8_BAR;
        PG8_WAIT_V(4); PG8_BAR;
        PG8_STAGE(PG8_SB(1, 0), cB + kstep, voffB); PG8_STAGE(PG8_SA(1, 0), cA + kstep, voffA); PG8_STAGE(PG8_SB(1, 1), cB + hstep + kstep, voffB);
        PG8_WAIT_V(6); PG8_BAR;
    }
    for (;;) {
        const bool has_next = S.next(ui + 1, nxt);
        const char* nA = has_next ? (const char*)g.A + (size_t)nxt.pm * tstep : cA; const char* nB = has_next ? (const char*)g.Bt + (size_t)nxt.pn * tstep : cB;
        for (int t = 0; t < nt; t += 2) {
            const bool last = (t == nt - 2);
            const char* a1 = cA + (size_t)(t + 1) * kstep;
            const char* a2 = last ? nA : cA + (size_t)(t + 2) * kstep; const char* b2 = last ? nB : cB + (size_t)(t + 2) * kstep;
            const char* a3 = a2 + kstep; const char* b3 = b2 + kstep;
            if (last && has_next) S.a_ready(nxt);
            if constexpr (SP2) {
            PG8_LDB(B0, 0, 0); PG8_LDB(B1, 0, 1); PG8_SCHED; PG8_LDA(At, 0, 0); PG8_STAGE(PG8_SA(1, 1), a1 + hstep, voffA);
            PG8_WAIT_V(8); PG8_WAIT_L(0); PG8_BAR; PG8_MMA(0, 0, At, B0); PG8_MMA(0, 1, At, B1); PG8_BAR; PG8_SCHED;
            PG8_LDA(At, 0, 1); PG8_STAGE(PG8_SB(0, 0), b2, voffB); PG8_STAGE(PG8_SB(0, 1), b2 + hstep, voffB); PG8_STAGE(PG8_SA(0, 0), a2, voffA);
            PG8_WAIT_V(8); PG8_WAIT_L(0); PG8_BAR; PG8_MMA(1, 0, At, B0); PG8_MMA(1, 1, At, B1); PG8_BAR; PG8_SCHED;
            PG8_LDB(B0, 1, 0); PG8_LDB(B1, 1, 1); PG8_SCHED; PG8_LDA(At, 1, 0); PG8_STAGE(PG8_SA(0, 1), a2 + hstep, voffA);
            PG8_WAIT_V(8); PG8_WAIT_L(0); PG8_BAR; PG8_MMA(0, 0, At, B0); PG8_MMA(0, 1, At, B1); PG8_BAR; PG8_SCHED;
            PG8_LDA(At, 1, 1); PG8_STAGE(PG8_SB(1, 0), b3, voffB); PG8_STAGE(PG8_SB(1, 1), b3 + hstep, voffB); PG8_STAGE(PG8_SA(1, 0), a3, voffA);
            PG8_WAIT_V(8); PG8_WAIT_L(0); PG8_BAR; PG8_MMA(1, 0, At, B0); PG8_MMA(1, 1, At, B1); PG8_BAR; PG8_SCHED;
            } else {
            PG8_LDB(B0, 0, 0); PG8_SCHED; PG8_LDA(At, 0, 0); PG8_STAGE(PG8_SA(1, 1), a1 + hstep, voffA);
            PG8_WAIT_L(8); PG8_BAR; PG8_WAIT_L(0); PG8_MMA(0, 0, At, B0); PG8_BAR; PG8_SCHED;
            PG8_LDB(B1, 0, 1); PG8_STAGE(PG8_SB(0, 0), b2, voffB);
            PG8_BAR; PG8_WAIT_L(0); PG8_MMA(0, 1, At, B1); PG8_BAR;
            PG8_LDA(At, 0, 1); PG8_STAGE(PG8_SA(0, 0), a2, voffA);
            PG8_BAR; PG8_WAIT_L(0); PG8_MMA(1, 0, At, B0); PG8_BAR; PG8_SCHED;
            PG8_STAGE(PG8_SB(0, 1), b2 + hstep, voffB);
            PG8_WAIT_V(6); PG8_BAR; PG8_MMA(1, 1, At, B1); PG8_BAR;
            PG8_LDB(B0, 1, 0); PG8_SCHED; PG8_LDA(At, 1, 0); PG8_STAGE(PG8_SA(0, 1), a2 + hstep, voffA);
            PG8_WAIT_L(8); PG8_BAR; PG8_WAIT_L(0); PG8_MMA(0, 0, At, B0); PG8_BAR; PG8_SCHED;
            PG8_LDB(B1, 1, 1); PG8_STAGE(PG8_SB(1, 0), b3, voffB);
            PG8_BAR; PG8_WAIT_L(0); PG8_MMA(0, 1, At, B1); PG8_BAR;
            PG8_LDA(At, 1, 1); PG8_STAGE(PG8_SA(1, 0), a3, voffA);
            PG8_BAR; PG8_WAIT_L(0); PG8_MMA(1, 0, At, B0); PG8_BAR; PG8_SCHED;
            PG8_STAGE(PG8_SB(1, 1), b3 + hstep, voffB);
            PG8_WAIT_V(6); PG8_BAR; PG8_MMA(1, 1, At, B1); PG8_BAR;
            }
        }
        if constexpr (ALIGN_EPI) { if (wr == 0) PG8_BAR; }
        if constexpr (!Epi::AFTER_DRAIN) { E(acc, cur, wr, wc, fr, fq); S.done(cur); }
        if (!has_next) break;
#pragma unroll
        for (int a = 0; a < 2; ++a)
#pragma unroll
            for (int b = 0; b < 2; ++b)
#pragma unroll
                for (int m = 0; m < 4; ++m)
#pragma unroll
                    for (int n = 0; n < 2; ++n) acc[a][b][m][n] = (f32x4){0.f, 0.f, 0.f, 0.f};
        cur = nxt; cA = nA; cB = nB; ++ui;
        if constexpr (ALIGN_EPI) { if (wr == 1) PG8_BAR; }
    }
    PG8_WAIT_V(0);
    if constexpr (!ALIGN_EPI) { if (wr == 0) PG8_BAR; }
    PG8_BAR;
    if constexpr (Epi::AFTER_DRAIN) { E.fused(acc, cur, wr, wc, fr, fq, lds, wid, lane); S.done(cur); }
#undef PG8_SA
#undef PG8_SB
#undef PG8_STAGE
#undef PG8_LDA
#undef PG8_LDB
#undef PG8_MMA
#undef PG8_WAIT_V
#undef PG8_WAIT_L
#undef PG8_BAR
#undef PG8_SCHED
}
}

using pg8::bf16_t; using pg8::bf16x8; using pg8::f32x4; using pg8::u32x4; using pg8::u32x2; using pg8::cvt_pk_bf16;

constexpr int S_ = 16384, D_ = 2048, DFF_ = 5632, INW_ = 4608, DEPTH_ = 2;
constexpr int LDS_BYTES = 131072 + 16;
constexpr size_t SZ_WIN = (size_t)2 * DFF_ * D_ * 2, SZ_WOUT = (size_t)D_ * DFF_ * 2, SZ_WMIN = (size_t)INW_ * D_ * 2, SZ_WMOUT = (size_t)D_ * D_ * 2;
constexpr size_t OFF_W1IN = 0, OFF_W1OUT = OFF_W1IN + SZ_WIN, OFF_WMIN = OFF_W1OUT + SZ_WOUT, OFF_WMOUT = OFF_WMIN + SZ_WMIN, OFF_W2IN = OFF_WMOUT + SZ_WMOUT, OFF_W2OUT = OFF_W2IN + SZ_WIN;
constexpr size_t OFF_POOLW = OFF_W2OUT + SZ_WOUT, OFF_GATEW = OFF_POOLW + 131072, OFF_LSUM = OFF_GATEW + 131072;
constexpr size_t OFF_XN = OFF_LSUM + 524288, OFF_HID = OFF_XN + (size_t)S_ * D_ * 2, OFF_H = OFF_HID + (size_t)S_ * DFF_ * 2, OFF_Y = OFF_H + (size_t)S_ * D_ * 2, OFF_BAR = OFF_Y + (size_t)S_ * D_ * 2, OFF_TS = OFF_BAR + 16384, OFF_RS = OFF_TS + 1024, OFF_QKV = OFF_RS + 65536, WS_END = OFF_QKV + (size_t)3 * 16 * S_ * 64 * 2;
constexpr int NPHASE = 1 + 11 * DEPTH_;

struct Params { const float* in[15]; float* out; unsigned char* ws; };

__device__ __forceinline__ int ltid() { int t = threadIdx.x; asm volatile("" : "+v"(t)); return t; }
__device__ __forceinline__ float bf2f(unsigned short b) { return __uint_as_float(((unsigned)b) << 16); }
__device__ __forceinline__ float wave_sum(float v) {
#pragma unroll
    for (int o = 32; o > 0; o >>= 1) v += __shfl_xor(v, o);
    return v;
}

__device__ __forceinline__ void convert_tile(LAS unsigned char* lds, const float* __restrict__ src, bf16_t* __restrict__ dst, int K, int srcN, int perm, int nt_idx, int kt_idx, int tid, const float* __restrict__ gk) {
    const int n = tid & 63, kg = tid >> 6;
    const int np0 = nt_idx * 64;
    int sc0 = np0;
    if (perm) { const int pn = np0 >> 8, bj = (np0 >> 7) & 1, j = np0 & 127; sc0 = bj * DFF_ + pn * 128 + j; }
    const float* s = src + (size_t)(kt_idx * 128 + kg * 16) * srcN + sc0 + n;
    float v[16];
#pragma unroll
    for (int i = 0; i < 16; ++i) v[i] = __builtin_nontemporal_load(s + (size_t)i * srcN);
    if (gk) {
#pragma unroll
        for (int i = 0; i < 16; ++i) v[i] *= gk[kt_idx * 128 + __builtin_amdgcn_readfirstlane(kg) * 16 + i]; }
#pragma unroll
    for (int i = 0; i < 4; ++i) { u32x2 w; w.x = cvt_pk_bf16(v[i * 4], v[i * 4 + 1]); w.y = cvt_pk_bf16(v[i * 4 + 2], v[i * 4 + 3]);
        *(LAS u32x2*)(lds + n * 264 + (kg * 4 + i) * 8) = w; }
    __syncthreads();
#pragma unroll
    for (int pass = 0; pass < 2; ++pass) { const int row = pass * 32 + (tid >> 4), c = tid & 15;
        const u32x2 a = *(const LAS u32x2*)(lds + row * 264 + c * 16), b = *(const LAS u32x2*)(lds + row * 264 + c * 16 + 8);
        u32x4 o; o.x = a.x; o.y = a.y; o.z = b.x; o.w = b.y;
        *(u32x4*)(dst + (size_t)(np0 + row) * K + kt_idx * 128 + c * 8) = o; }
    __syncthreads();
}

__device__ __forceinline__ void convert_phase(LAS unsigned char* lds, const Params& p, int layer) {
    unsigned char* ws = p.ws; const int tid = ltid();
    const int ntiles[6] = {2816, 1408, 1152, 512, 2816, 1408};
    int total = 0;
#pragma unroll
    for (int j = 0; j < 6; ++j) total += ntiles[j];
    for (int T = blockIdx.x; T < total; T += gridDim.x) {
        int loc = T; int job = 0;
#pragma unroll
        for (int j = 0; j < 5; ++j) if (job == j && loc >= ntiles[j]) { loc -= ntiles[j]; job = j + 1; }
        const float* src; bf16_t* dst; int K, srcN, perm, ntn; const float* gk = nullptr; const float* gl = p.in[1] + (size_t)layer * 6 * D_;
        switch (job) {
            case 0: src = p.in[2] + (size_t)layer * D_ * 2 * DFF_; dst = (bf16_t*)(ws + OFF_W1IN); K = D_; srcN = 2 * DFF_; perm = 1; ntn = 2 * DFF_ / 64; gk = gl; break;
            case 1: src = p.in[3] + (size_t)layer * DFF_ * D_; dst = (bf16_t*)(ws + OFF_W1OUT); K = DFF_; srcN = D_; perm = 0; ntn = D_ / 64; break;
            case 2: src = p.in[4] + (size_t)layer * D_ * INW_; dst = (bf16_t*)(ws + OFF_WMIN); K = D_; srcN = INW_; perm = 0; ntn = INW_ / 64; gk = gl + 2 * D_; break;
            case 3: src = p.in[5] + (size_t)layer * D_ * D_; dst = (bf16_t*)(ws + OFF_WMOUT); K = D_; srcN = D_; perm = 0; ntn = D_ / 64; break;
            case 4: src = p.in[13] + (size_t)layer * D_ * 2 * DFF_; dst = (bf16_t*)(ws + OFF_W2IN); K = D_; srcN = 2 * DFF_; perm = 1; ntn = 2 * DFF_ / 64; gk = gl + 4 * D_; break;
            default: src = p.in[14] + (size_t)layer * DFF_ * D_; dst = (bf16_t*)(ws + OFF_W2OUT); K = DFF_; srcN = D_; perm = 0; ntn = D_ / 64; break;
        }
        const int kt = loc / ntn, nt = loc - kt * ntn;
        convert_tile(lds, src, dst, K, srcN, perm, nt, kt, tid, gk);
    }
    const float* pw = p.in[6] + (size_t)layer * 65536; const float* gw = p.in[10] + (size_t)layer * 65536;
    bf16_t* pwt = (bf16_t*)(ws + OFF_POOLW); bf16_t* gwt = (bf16_t*)(ws + OFF_GATEW);
    for (int i = blockIdx.x * 512 + tid; i < 131072; i += gridDim.x * 512) {
        if (i < 65536) { const int g = i >> 14, d = (i >> 7) & 127, c = i & 127; pwt[i] = (bf16_t)(cvt_pk_bf16(pw[(g * 128 + c) * 128 + d], 0.f) & 0xffffu); }
        else { const int k = i - 65536; const int gh = k >> 12, d = (k >> 6) & 63, c = k & 63; gwt[k] = (bf16_t)(cvt_pk_bf16(gw[(gh * 64 + c) * 64 + d], 0.f) & 0xffffu); }
    }
}

__device__ __forceinline__ void norm_phase(const bf16_t* __restrict__ h, const float* __restrict__ xin, bf16_t* XB, float coef, const float* __restrict__ ga, float* __restrict__ RS, float* __restrict__ out) {
    const int tid = ltid(); const int lane = tid & 63, gwv = blockIdx.x * 8 + (tid >> 6), GW = gridDim.x * 8;
    for (int row0 = gwv; row0 < S_; row0 += 2 * GW) {
        const int row1 = (row0 + GW < S_) ? row0 + GW : row0;
        f32x4 xa[8], xb[8];
        if (xin) {
            const f32x4* xr0 = (const f32x4*)(xin + (size_t)row0 * D_); const f32x4* xr1 = (const f32x4*)(xin + (size_t)row1 * D_);
#pragma unroll
            for (int i = 0; i < 8; ++i) { xa[i] = xr0[lane + i * 64]; xb[i] = xr1[lane + i * 64]; }
        } else {
            const u32x2* xr0 = (const u32x2*)(XB + (size_t)row0 * D_); const u32x2* xr1 = (const u32x2*)(XB + (size_t)row1 * D_);
            u32x2 wa[8], wb[8];
#pragma unroll
            for (int i = 0; i < 8; ++i) { wa[i] = xr0[lane + i * 64]; wb[i] = xr1[lane + i * 64]; }
#pragma unroll
            for (int i = 0; i < 8; ++i) {
                xa[i] = (f32x4){__uint_as_float(wa[i].x << 16), __uint_as_float(wa[i].x & 0xffff0000u), __uint_as_float(wa[i].y << 16), __uint_as_float(wa[i].y & 0xffff0000u)};
                xb[i] = (f32x4){__uint_as_float(wb[i].x << 16), __uint_as_float(wb[i].x & 0xffff0000u), __uint_as_float(wb[i].y << 16), __uint_as_float(wb[i].y & 0xffff0000u)}; }
        }
        if (h) {
            u32x2 ha[8], hb[8];
            const u32x2* hr0 = (const u32x2*)(h + (size_t)row0 * D_); const u32x2* hr1 = (const u32x2*)(h + (size_t)row1 * D_);
#pragma unroll
            for (int i = 0; i < 8; ++i) { ha[i] = hr0[lane + i * 64]; hb[i] = hr1[lane + i * 64]; }
            float s0 = 0.f, s1 = 0.f;
#pragma unroll
            for (int i = 0; i < 8; ++i) {
                const float a0 = __uint_as_float(ha[i].x << 16), a1 = __uint_as_float(ha[i].x & 0xffff0000u), a2 = __uint_as_float(ha[i].y << 16), a3 = __uint_as_float(ha[i].y & 0xffff0000u);
                const float b0 = __uint_as_float(hb[i].x << 16), b1 = __uint_as_float(hb[i].x & 0xffff0000u), b2 = __uint_as_float(hb[i].y << 16), b3 = __uint_as_float(hb[i].y & 0xffff0000u);
                s0 += a0 * a0 + a1 * a1 + a2 * a2 + a3 * a3; s1 += b0 * b0 + b1 * b1 + b2 * b2 + b3 * b3; }
            s0 = wave_sum(s0); s1 = wave_sum(s1);
            const float r0 = coef * rsqrtf(s0 * (1.0f / D_) + 1e-6f), r1 = coef * rsqrtf(s1 * (1.0f / D_) + 1e-6f);
#pragma unroll
            for (int i = 0; i < 8; ++i) { const f32x4 g = ((const f32x4*)ga)[lane + i * 64];
                const f32x4 hva = (f32x4){__uint_as_float(ha[i].x << 16), __uint_as_float(ha[i].x & 0xffff0000u), __uint_as_float(ha[i].y << 16), __uint_as_float(ha[i].y & 0xffff0000u)};
                const f32x4 hvb = (f32x4){__uint_as_float(hb[i].x << 16), __uint_as_float(hb[i].x & 0xffff0000u), __uint_as_float(hb[i].y << 16), __uint_as_float(hb[i].y & 0xffff0000u)};
                xa[i] = xa[i] + hva * g * r0; xb[i] = xb[i] + hvb * g * r1; }
        }
        if (out) {
            f32x4* xw0 = (f32x4*)(out + (size_t)row0 * D_); f32x4* xw1 = (f32x4*)(out + (size_t)row1 * D_);
#pragma unroll
            for (int i = 0; i < 8; ++i) { xw0[lane + i * 64] = xa[i]; xw1[lane + i * 64] = xb[i]; }
        } else {
            float s0 = 0.f, s1 = 0.f;
#pragma unroll
            for (int i = 0; i < 8; ++i) { s0 += xa[i][0] * xa[i][0] + xa[i][1] * xa[i][1] + xa[i][2] * xa[i][2] + xa[i][3] * xa[i][3]; s1 += xb[i][0] * xb[i][0] + xb[i][1] * xb[i][1] + xb[i][2] * xb[i][2] + xb[i][3] * xb[i][3]; }
            s0 = wave_sum(s0); s1 = wave_sum(s1);
            if (lane == 0) { RS[row0] = rsqrtf(s0 * (1.0f / D_) + 1e-6f); RS[row1] = rsqrtf(s1 * (1.0f / D_) + 1e-6f); }
            u32x2* xo0 = (u32x2*)(XB + (size_t)row0 * D_); u32x2* xo1 = (u32x2*)(XB + (size_t)row1 * D_);
#pragma unroll
            for (int i = 0; i < 8; ++i) { u32x2 w0, w1; w0.x = cvt_pk_bf16(xa[i][0], xa[i][1]); w0.y = cvt_pk_bf16(xa[i][2], xa[i][3]); w1.x = cvt_pk_bf16(xb[i][0], xb[i][1]); w1.y = cvt_pk_bf16(xb[i][2], xb[i][3]);
                xo0[lane + i * 64] = w0; xo1[lane + i * 64] = w1; }
        }
    }
}

#define MFMA16(a, b, c) __builtin_amdgcn_mfma_f32_16x16x32_bf16((a), (b), (c), 0, 0, 0)

typedef short s16x4 __attribute__((ext_vector_type(4)));
__device__ __forceinline__ void attn_chunk_geom(int ci, int P0, int& kb, int& sh, int& ksel) {
    if (ci < 12) { sh = 0; kb = P0 - 128 + ci * 32; ksel = -1; } else if (ci < 18) { sh = 2; kb = P0 - 512 + ((ci - 12) * 32) * 4; ksel = -1; }
    else { const int k = (ci - 18) / 5, c = (ci - 18) - 5 * k; sh = 4; kb = P0 + 4 * k - 2048 + (c * 32) * 16; ksel = k; }
}
__device__ __forceinline__ void attn_load(const bf16_t* __restrict__ zk, const bf16_t* __restrict__ zv, int kb, int sh, int fr, int lane, bf16x8 (&kq)[4], bf16x8 (&vq)[4]) {
#pragma unroll
    for (int t = 0; t < 2; ++t) { int kp = kb + ((t * 16 + fr) << sh); kp = kp < 0 ? 0 : (kp > S_ - 1 ? S_ - 1 : kp);
        const bf16_t* kr = zk + (size_t)kp * 64; kq[t * 2] = *(const bf16x8*)kr; kq[t * 2 + 1] = *(const bf16x8*)(kr + 32); }
#pragma unroll
    for (int i = 0; i < 4; ++i) { int kp = kb + ((i * 8 + (lane >> 3)) << sh); kp = kp < 0 ? 0 : (kp > S_ - 1 ? S_ - 1 : kp);
        vq[i] = *(const bf16x8*)(zv + (size_t)kp * 64); }
}
__device__ __forceinline__ float xmax_16_32(float v) {
    const unsigned u = __float_as_uint(v);
    const auto r = __builtin_amdgcn_permlane16_swap(u, u, false, false);
    const float w = fmaxf(__uint_as_float(r[0]), __uint_as_float(r[1]));
    const unsigned u2 = __float_as_uint(w);
    const auto r2 = __builtin_amdgcn_permlane32_swap(u2, u2, false, false);
    return fmaxf(__uint_as_float(r2[0]), __uint_as_float(r2[1]));
}
__device__ __forceinline__ void attn_tile(const bf16x8 (&kq)[4], const bf16x8 (&vf)[4], int dbase, int sh, int lim, float nslope2, const bf16x8 qf0, const bf16x8 qf1, float& m, float& l, f32x4 (&o)[4]) {
    f32x4 st[2];
#pragma unroll
    for (int t = 0; t < 2; ++t) { st[t] = MFMA16(kq[t * 2], qf0, ((f32x4){0.f, 0.f, 0.f, 0.f})); st[t] = MFMA16(kq[t * 2 + 1], qf1, st[t]); }
    const float b0 = nslope2 * (float)dbase, bstep = nslope2 * (float)(1 << sh);
    float sv[8]; float cmax = -1e30f;
#pragma unroll
    for (int i = 0; i < 8; ++i) {
        const int c = (i >> 2) * 16 + (i & 3);
        const int delta = dbase - (c << sh);
        const float bias = b0 - bstep * (float)c;
        const float s2 = fmaf(st[i >> 2][i & 3], 0.125f * 1.44269504f, bias);
        sv[i] = ((unsigned)delta <= (unsigned)lim) ? s2 : -1e30f;
        cmax = fmaxf(cmax, sv[i]);
    }
    cmax = xmax_16_32(cmax);
    const float mn = fmaxf(m, cmax), alpha = __builtin_amdgcn_exp2f(m - mn);
    m = mn;
    float ps = 0.f; float pv[8];
#pragma unroll
    for (int i = 0; i < 8; ++i) { pv[i] = __builtin_amdgcn_exp2f(sv[i] - mn); ps += pv[i]; }
    l = l * alpha + ps;
    u32x4 pw; pw.x = cvt_pk_bf16(pv[0], pv[1]); pw.y = cvt_pk_bf16(pv[2], pv[3]); pw.z = cvt_pk_bf16(pv[4], pv[5]); pw.w = cvt_pk_bf16(pv[6], pv[7]);
    const bf16x8 pf = __builtin_bit_cast(bf16x8, pw);
#pragma unroll
    for (int dvt = 0; dvt < 4; ++dvt) { o[dvt] = o[dvt] * alpha; o[dvt] = MFMA16(vf[dvt], pf, o[dvt]); }
}
__device__ __forceinline__ void attn_chunk4(const bf16x8 (&kq)[4], const bf16x8 (&vq)[4], int kb, int sh, int ksel, LAS unsigned char* vst, LAS unsigned char* vrd, const bf16x8 (&qf)[4][2],
                                            int pq0, int fq, float slope, float (&m)[4], float (&l)[4], f32x4 (&o)[4][4]) {
#pragma unroll
    for (int i = 0; i < 4; ++i) *(LAS bf16x8*)(vst + i * 8 * 144) = vq[i];
    bf16x8 vf[4];
#pragma unroll
    for (int dvt = 0; dvt < 4; ++dvt) {
        const s16x4 lo = __builtin_amdgcn_ds_read_tr16_b64_v4i16((LAS s16x4*)(vrd + dvt * 32));
        const s16x4 hi = __builtin_amdgcn_ds_read_tr16_b64_v4i16((LAS s16x4*)(vrd + 16 * 144 + dvt * 32));
        vf[dvt] = (bf16x8){lo[0], lo[1], lo[2], lo[3], hi[0], hi[1], hi[2], hi[3]};
    }
#pragma unroll
    for (int k = 0; k < 4; ++k) if (ksel < 0 || ksel == k) { const int pq = pq0 + 4 * k, wmax = 128 << sh;
        attn_tile(kq, vf, pq - kb - ((fq * 4) << sh), sh, pq < wmax ? pq : wmax, slope, qf[k][0], qf[k][1], m[k], l[k], o[k]); }
}
__device__ __forceinline__ void attn_chunkA(const bf16x8 (&kq)[4], const bf16x8 (&vq)[4], int kb, int c, LAS unsigned char* vst, LAS unsigned char* vrd, const bf16x8 (&qf)[4][2],
                                            int pqA0, int fq, float slope, float (&m)[4], float (&l)[4], f32x4 (&o)[4][4]) {
#pragma unroll
    for (int i = 0; i < 4; ++i) *(LAS bf16x8*)(vst + i * 8 * 144) = vq[i];
    bf16x8 vf[4];
#pragma unroll
    for (int dvt = 0; dvt < 4; ++dvt) {
        const s16x4 lo = __builtin_amdgcn_ds_read_tr16_b64_v4i16((LAS s16x4*)(vrd + dvt * 32));
        const s16x4 hi = __builtin_amdgcn_ds_read_tr16_b64_v4i16((LAS s16x4*)(vrd + 16 * 144 + dvt * 32));
        vf[dvt] = (bf16x8){lo[0], lo[1], lo[2], lo[3], hi[0], hi[1], hi[2], hi[3]};
    }
#pragma unroll
    for (int t = 0; t < 4; ++t) if (c >= 2 * t && c <= 2 * t + 5) { const int pq = pqA0 + 64 * t;
        attn_tile(kq, vf, pq - kb - fq * 4, 0, pq < 128 ? pq : 128, slope, qf[t][0], qf[t][1], m[t], l[t], o[t]); }
}
__device__ __forceinline__ void attn_item(LAS unsigned char* vl, const bf16_t* __restrict__ z, bf16_t* __restrict__ y, int Bblk, int head, int rho, int lane) {
    const int fr = lane & 15, fq = lane >> 4;
    const int P0 = Bblk * 256 + rho, pq0 = P0 + 16 * fr, pqA0 = P0 + 4 * fr;
    const float slope = -1.44269504f * exp2f(-0.5f * (float)(head + 1));
    const bf16_t* zk = z + (size_t)(16 + head) * S_ * 64 + fq * 8;
    const bf16_t* zv = z + (size_t)(32 + head) * S_ * 64 + (lane & 7) * 8;
    LAS unsigned char* vst = vl + (lane >> 3) * 144 + (lane & 7) * 16;
    LAS unsigned char* vrd = vl + (fq * 4 + (fr >> 2)) * 144 + (fr & 3) * 8;
    float m[4], l[4]; f32x4 o[4][4];
#pragma unroll
    for (int k = 0; k < 4; ++k) { m[k] = -1e30f; l[k] = 0.f;
#pragma unroll
        for (int i = 0; i < 4; ++i) o[k][i] = (f32x4){0.f, 0.f, 0.f, 0.f}; }
    bf16x8 k0[4], v0[4], k1[4], v1[4];
    int kb, sh, ks, kbn, shn, ksn;
    {
        const bf16_t* zqA = z + ((size_t)head * S_ + pqA0) * 64 + fq * 8;
        bf16x8 qf[4][2];
#pragma unroll
        for (int t = 0; t < 4; ++t) { qf[t][0] = *(const bf16x8*)(zqA + t * 64 * 64); qf[t][1] = *(const bf16x8*)(zqA + t * 64 * 64 + 32); }
        attn_chunk_geom(0, P0, kb, sh, ks); attn_load(zk, zv, kb, sh, fr, lane, k0, v0);
#pragma unroll 1
        for (int c = 0; c < 12; c += 2) {
            attn_chunk_geom(c + 1, P0, kbn, shn, ksn); attn_load(zk, zv, kbn, shn, fr, lane, k1, v1);
            attn_chunk_geom(c, P0, kb, sh, ks); attn_chunkA(k0, v0, kb, c, vst, vrd, qf, pqA0, fq, slope, m, l, o);
            attn_chunk_geom(c + 2, P0, kbn, shn, ksn); attn_load(zk, zv, kbn, shn, fr, lane, k0, v0);
            attn_chunk_geom(c + 1, P0, kb, sh, ks); attn_chunkA(k1, v1, kb, c + 1, vst, vrd, qf, pqA0, fq, slope, m, l, o);
        }
    }
    {
        LAS float* rec = (LAS float*)vl;
        f32x4 o2[4][4]; float m2[4], l2[4];
        asm volatile("" ::: "memory");
#pragma unroll
        for (int h = 0; h < 2; ++h) {
#pragma unroll
            for (int t = 0; t < 4; ++t) { LAS float* w = rec + ((16 * t + fr) * 4 + fq) * 9;
#pragma unroll
                for (int e = 0; e < 4; ++e) { w[e] = o[t][2 * h][e]; w[4 + e] = o[t][2 * h + 1][e]; }
                w[8] = h ? l[t] : m[t]; }
#pragma unroll
            for (int k = 0; k < 4; ++k) { const LAS float* r = rec + ((16 * (fr >> 2) + (fr & 3) * 4 + k) * 4 + fq) * 9;
#pragma unroll
                for (int e = 0; e < 4; ++e) { o2[k][2 * h][e] = r[e]; o2[k][2 * h + 1][e] = r[4 + e]; }
                if (h) l2[k] = r[8]; else m2[k] = r[8]; }
            asm volatile("" ::: "memory");
        }
#pragma unroll
        for (int k = 0; k < 4; ++k) { m[k] = m2[k]; l[k] = l2[k];
#pragma unroll
            for (int i = 0; i < 4; ++i) o[k][i] = o2[k][i]; }
    }
    {
        const bf16_t* zq = z + ((size_t)head * S_ + pq0) * 64 + fq * 8;
        bf16x8 qf[4][2];
#pragma unroll
        for (int k = 0; k < 4; ++k) { qf[k][0] = *(const bf16x8*)(zq + k * 4 * 64); qf[k][1] = *(const bf16x8*)(zq + k * 4 * 64 + 32); }
#pragma unroll 1
        for (int ci = 12; ci < 38; ci += 2) {
            attn_chunk_geom(ci + 1, P0, kbn, shn, ksn); attn_load(zk, zv, kbn, shn, fr, lane, k1, v1);
            attn_chunk_geom(ci, P0, kb, sh, ks); attn_chunk4(k0, v0, kb, sh, ks, vst, vrd, qf, pq0, fq, slope, m, l, o);
            attn_chunk_geom(ci + 2 < 38 ? ci + 2 : 37, P0, kbn, shn, ksn); attn_load(zk, zv, kbn, shn, fr, lane, k0, v0);
            attn_chunk_geom(ci + 1, P0, kb, sh, ks); attn_chunk4(k1, v1, kb, sh, ks, vst, vrd, qf, pq0, fq, slope, m, l, o);
        }
    }
#pragma unroll
    for (int k = 0; k < 4; ++k) {
        float lk = l[k]; lk += __shfl_xor(lk, 16); lk += __shfl_xor(lk, 32);
        const float inv = 1.0f / lk;
        bf16_t* yo = y + (size_t)(pq0 + 4 * k) * D_ + 1024 + head * 64 + fq * 4;
#pragma unroll
        for (int dvt = 0; dvt < 4; ++dvt) { u32x2 w; w.x = cvt_pk_bf16(o[k][dvt][0] * inv, o[k][dvt][1] * inv); w.y = cvt_pk_bf16(o[k][dvt][2] * inv, o[k][dvt][3] * inv); *(u32x2*)(yo + dvt * 16) = w; }
    }
}

#ifndef POOL_PREF_MAX
#define POOL_PREF_MAX 16
#endif
template <int WIN> __device__ __forceinline__ void pool_load(const bf16_t* __restrict__ zc, int t, bf16x8 (&d)[WIN]) {
#pragma unroll
    for (int j = 0; j < WIN; ++j) { const int tj = t - j; d[j] = *(const bf16x8*)(zc + (size_t)(tj < 0 ? 0 : tj) * INW_); }
}
template <int WIN> __device__ __forceinline__ void pool_item(const bf16_t* __restrict__ z, bf16_t* __restrict__ y, const bf16_t* __restrict__ pwt, const float* __restrict__ scale, int item, int lane) {
    const int fr = lane & 15, fq = lane >> 4;
    constexpr int win = WIN, gi = (WIN == 2) ? 0 : (WIN == 4) ? 1 : (WIN == 8) ? 2 : 3; const int t = item * 16 + fr;
    const float invn = 1.0f / (float)((t + 1) < win ? (t + 1) : win);
    const bf16_t* wb = pwt + (size_t)gi * 16384 + fr * 128 + fq * 8;
    const bf16_t* zb = z + gi * 128 + fq * 8;
    f32x4 acc[8];
#pragma unroll
    for (int dt = 0; dt < 8; ++dt) acc[dt] = (f32x4){0.f, 0.f, 0.f, 0.f};
    constexpr bool PREF = (WIN <= POOL_PREF_MAX);
    bf16x8 zc[WIN], zn[WIN];
    pool_load<WIN>(zb, t, zc);
#pragma unroll 1
    for (int kk = 0; kk < 4; ++kk) {
        if (PREF) pool_load<WIN>(zb + (kk < 3 ? kk + 1 : 3) * 32, t, zn);
        float s[8];
#pragma unroll
        for (int e = 0; e < 8; ++e) s[e] = 0.f;
#pragma unroll
        for (int j = 0; j < win; ++j) { const float f = (t - j >= 0) ? 1.0f : 0.0f;
#pragma unroll
            for (int e = 0; e < 8; ++e) s[e] += f * bf2f((unsigned short)zc[j][e]); }
        u32x4 w;
        w.x = cvt_pk_bf16(s[0] * invn - bf2f((unsigned short)zc[0][0]), s[1] * invn - bf2f((unsigned short)zc[0][1]));
        w.y = cvt_pk_bf16(s[2] * invn - bf2f((unsigned short)zc[0][2]), s[3] * invn - bf2f((unsigned short)zc[0][3]));
        w.z = cvt_pk_bf16(s[4] * invn - bf2f((unsigned short)zc[0][4]), s[5] * invn - bf2f((unsigned short)zc[0][5]));
        w.w = cvt_pk_bf16(s[6] * invn - bf2f((unsigned short)zc[0][6]), s[7] * invn - bf2f((unsigned short)zc[0][7]));
        const bf16x8 pf = __builtin_bit_cast(bf16x8, w);
#pragma unroll
        for (int dt = 0; dt < 8; ++dt) { const bf16x8 wf = *(const bf16x8*)(wb + dt * 16 * 128 + kk * 32); acc[dt] = MFMA16(wf, pf, acc[dt]); }
        if (kk < 3) { if (PREF) {
#pragma unroll
            for (int j = 0; j < WIN; ++j) zc[j] = zn[j]; } else pool_load<WIN>(zb + (kk + 1) * 32, t, zc); }
    }
    bf16_t* yo = y + (size_t)t * D_ + gi * 128 + fq * 4;
    const float* sc = scale + gi * 128 + fq * 4;
    f32x4 s4[8];
#pragma unroll
    for (int dt = 0; dt < 8; ++dt) s4[dt] = *(const f32x4*)(sc + dt * 16);
    asm volatile("" :: "v"(s4[0]), "v"(s4[1]), "v"(s4[2]), "v"(s4[3]), "v"(s4[4]), "v"(s4[5]), "v"(s4[6]), "v"(s4[7]));
#pragma unroll
    for (int dt = 0; dt < 8; ++dt) {
        u32x2 w; w.x = cvt_pk_bf16(acc[dt][0] * s4[dt][0], acc[dt][1] * s4[dt][1]); w.y = cvt_pk_bf16(acc[dt][2] * s4[dt][2], acc[dt][3] * s4[dt][3]);
        *(u32x2*)(yo + dt * 16) = w;
    }
}

__device__ __forceinline__ void lru_item(LAS unsigned char* wlds, const bf16_t* __restrict__ z, const Params& p, int layer, const bf16_t* __restrict__ gwt,
                                         float* __restrict__ HL, float* __restrict__ PC, float* __restrict__ sumP, float* __restrict__ sumH, int item, int lane) {
    const int fr = lane & 15, fq = lane >> 4;
    const int hh = item & 7, ck = item >> 3, T0 = ck * 128;
    const float* convw = p.in[8] + (size_t)layer * 4 * 512 + hh * 64;
    const float* convb = p.in[9] + (size_t)layer * 512 + hh * 64;
    const float* gb = p.in[11] + (size_t)layer * 1024;
    const float* lam = p.in[12] + (size_t)layer * 512 + hh * 64;
    LAS float* Al = (LAS float*)wlds; LAS float* Gl = (LAS float*)(wlds + 4224);
    float br_[4], bi_[4], sp_[4];
#pragma unroll
    for (int nt = 0; nt < 4; ++nt) { const int d = nt * 16 + fr; br_[nt] = gb[hh * 64 + d]; bi_[nt] = gb[512 + hh * 64 + d];
        const float nl = -lam[d]; sp_[nt] = (nl > 20.f) ? nl : log1pf(__expf(nl)); }
    const float w0 = convw[lane], w1 = convw[512 + lane], w2 = convw[1024 + lane], w3 = convw[1536 + lane], cb = convb[lane];
    const bf16_t* zx = z + 512 + hh * 64;
    float xm3 = (T0 >= 3) ? bf2f(zx[(size_t)(T0 - 3) * INW_ + lane]) : 0.f, xm2 = (T0 >= 2) ? bf2f(zx[(size_t)(T0 - 2) * INW_ + lane]) : 0.f, xm1 = (T0 >= 1) ? bf2f(zx[(size_t)(T0 - 1) * INW_ + lane]) : 0.f;
    float hst = 0.f, pst = 1.f;
    bf16x8 gwr[4][2], gwi[4][2];
#pragma unroll
    for (int nt = 0; nt < 4; ++nt)
#pragma unroll
        for (int kk = 0; kk < 2; ++kk) { gwr[nt][kk] = *(const bf16x8*)(gwt + (size_t)(hh * 64 + nt * 16 + fr) * 64 + kk * 32 + fq * 8);
            gwi[nt][kk] = *(const bf16x8*)(gwt + (size_t)((8 + hh) * 64 + nt * 16 + fr) * 64 + kk * 32 + fq * 8); }
    asm volatile("" :: "v"(gwr[0][0]), "v"(gwr[0][1]), "v"(gwr[1][0]), "v"(gwr[1][1]), "v"(gwr[2][0]), "v"(gwr[2][1]), "v"(gwr[3][0]), "v"(gwr[3][1]),
                 "v"(gwi[0][0]), "v"(gwi[0][1]), "v"(gwi[1][0]), "v"(gwi[1][1]), "v"(gwi[2][0]), "v"(gwi[2][1]), "v"(gwi[3][0]), "v"(gwi[3][1]));
    LAS float* wl = (LAS float*)(wlds + 8448);
    wl[lane] = w0; wl[64 + lane] = w1; wl[128 + lane] = w2; wl[192 + lane] = w3; wl[256 + lane] = cb;
    asm volatile("s_waitcnt lgkmcnt(0)" ::: "memory");
    bf16x8 zin[2][4], znx[2][4]; unsigned short xzr[16];
#define LRU_LOAD(ZI, TT0) do { _Pragma("unroll") for (int kk = 0; kk < 2; ++kk) _Pragma("unroll") for (int tap = 0; tap < 4; ++tap) { const int tj = (TT0) + fr - 3 + tap; \
            ZI[kk][tap] = *(const bf16x8*)(zx + (size_t)(tj < 0 ? 0 : tj) * INW_ + kk * 32 + fq * 8); } } while (0)
    LRU_LOAD(zin, T0);
    for (int sub = 0; sub < 8; ++sub) {
        const int t0 = T0 + sub * 16, t = t0 + fr;
#pragma unroll
        for (int tt = 0; tt < 16; ++tt) xzr[tt] = zx[(size_t)(t0 + tt) * INW_ + lane];
        { const int tn = (sub < 7) ? t0 + 16 : t0; LRU_LOAD(znx, tn); }
        bf16x8 xf[2];
#pragma unroll
        for (int kk = 0; kk < 2; ++kk) {
            const int c0 = kk * 32 + fq * 8;
            float a[8];
            { const f32x4 b0 = *(const LAS f32x4*)(wl + 256 + c0), b1 = *(const LAS f32x4*)(wl + 256 + c0 + 4); a[0] = b0[0]; a[1] = b0[1]; a[2] = b0[2]; a[3] = b0[3]; a[4] = b1[0]; a[5] = b1[1]; a[6] = b1[2]; a[7] = b1[3]; }
#pragma unroll
            for (int tap = 0; tap < 4; ++tap) { const float f = (t - 3 + tap >= 0) ? 1.0f : 0.0f;
                const f32x4 wa = *(const LAS f32x4*)(wl + tap * 64 + c0) * f, wb = *(const LAS f32x4*)(wl + tap * 64 + c0 + 4) * f;
                const bf16x8 v = zin[kk][tap];
                a[0] += wa[0] * bf2f((unsigned short)v[0]); a[1] += wa[1] * bf2f((unsigned short)v[1]); a[2] += wa[2] * bf2f((unsigned short)v[2]); a[3] += wa[3] * bf2f((unsigned short)v[3]);
                a[4] += wb[0] * bf2f((unsigned short)v[4]); a[5] += wb[1] * bf2f((unsigned short)v[5]); a[6] += wb[2] * bf2f((unsigned short)v[6]); a[7] += wb[3] * bf2f((unsigned short)v[7]); }
            u32x4 w; w.x = cvt_pk_bf16(a[0], a[1]); w.y = cvt_pk_bf16(a[2], a[3]); w.z = cvt_pk_bf16(a[4], a[5]); w.w = cvt_pk_bf16(a[6], a[7]);
            xf[kk] = __builtin_bit_cast(bf16x8, w);
        }
#pragma unroll
        for (int nt = 0; nt < 4; ++nt) {
            f32x4 ar = (f32x4){0.f, 0.f, 0.f, 0.f}, ai = (f32x4){0.f, 0.f, 0.f, 0.f};
#pragma unroll
            for (int kk = 0; kk < 2; ++kk) {
                ar = MFMA16(xf[kk], gwr[nt][kk], ar); ai = MFMA16(xf[kk], gwi[nt][kk], ai);
            }
#pragma unroll
            for (int j = 0; j < 4; ++j) {
                const float rg = __builtin_amdgcn_rcpf(1.0f + __expf(-(ar[j] + br_[nt]))), ig = __builtin_amdgcn_rcpf(1.0f + __expf(-(ai[j] + bi_[nt])));
                const float la = -8.0f * rg * sp_[nt];
                const float av = __expf(la), gu = sqrtf(fmaxf(1.0f - av * av, 0.f)) * ig;
                Al[(fq * 4 + j) * 66 + nt * 16 + fr] = av; Gl[(fq * 4 + j) * 66 + nt * 16 + fr] = gu;
            }
        }
        asm volatile("s_waitcnt lgkmcnt(0)" ::: "memory");
        float avv[16], guv[16];
#pragma unroll
        for (int tt = 0; tt < 16; ++tt) { avv[tt] = Al[tt * 66 + lane]; guv[tt] = Gl[tt * 66 + lane]; }
        asm volatile("s_waitcnt lgkmcnt(0)" ::: "memory");
#pragma unroll
        for (int tt = 0; tt < 16; ++tt) {
            const float xv = bf2f(xzr[tt]);
            const float xc = cb + w0 * xm3 + w1 * xm2 + w2 * xm1 + w3 * xv;
            xm3 = xm2; xm2 = xm1; xm1 = xv;
            const float av = avv[tt], gu = guv[tt];
            hst = av * hst + gu * xc; pst = pst * av;
            HL[(size_t)(t0 + tt) * 512 + hh * 64 + lane] = hst; PC[(size_t)(t0 + tt) * 512 + hh * 64 + lane] = pst;
        }
        asm volatile("s_waitcnt lgkmcnt(0)" ::: "memory");
#pragma unroll
        for (int kk = 0; kk < 2; ++kk)
#pragma unroll
            for (int tap = 0; tap < 4; ++tap) zin[kk][tap] = znx[kk][tap];
    }
#undef LRU_LOAD
    sumP[(hh * 64 + lane) * 128 + ck] = pst; sumH[(hh * 64 + lane) * 128 + ck] = hst;
}

__device__ __forceinline__ void mixers_phase(LAS unsigned char* lds, const Params& p, int layer, bool pool_here) {
    const bf16_t* z = (const bf16_t*)(p.ws + OFF_HID); bf16_t* y = (bf16_t*)(p.ws + OFF_Y);
    float* HL = (float*)(p.ws + OFF_H); float* PC = HL + (size_t)S_ * 512;
    float* sumP = (float*)(p.ws + OFF_LSUM); float* sumH = sumP + 128 * 512;
    const int tid = ltid(); const int lane = tid & 63;
    const int wid = __builtin_amdgcn_readfirstlane(tid >> 6);
    const int gwv = blockIdx.x * 8 + wid, GW = gridDim.x * 8;
    const bf16_t* pwt = (const bf16_t*)(p.ws + OFF_POOLW); const float* psc = p.in[7] + (size_t)layer * 512;
    const int G = gridDim.x;
#ifdef PROBE_PH_A
#define E1_STAMP(K) do { if (blockIdx.x == 0 && tid == 0 && layer == 0) __hip_atomic_store((unsigned long long*)(p.ws + OFF_TS) + 40 + (K), (unsigned long long)__builtin_amdgcn_s_memrealtime(), __ATOMIC_RELAXED, __HIP_MEMORY_SCOPE_AGENT); } while (0)
#else
#define E1_STAMP(K) do {} while (0)
#endif
    E1_STAMP(0);
    for (int i = blockIdx.x * 4 + wid; i < 1024; i += G * 4) {
        if (wid < 4) lru_item(lds + wid * 16384, z, p, layer, (const bf16_t*)(p.ws + OFF_GATEW), HL, PC, sumP, sumH, i, lane);
#ifdef DUP_LRU
        if (wid < 4) lru_item(lds + wid * 16384, z, p, layer, (const bf16_t*)(p.ws + OFF_GATEW), HL, PC, sumP, sumH, i, lane);
#endif
    }
    E1_STAMP(1);
    if ((G & 7) == 0) {
        const int xcd = blockIdx.x & 7, lw = (blockIdx.x >> 3) * 8 + wid, nlw = (G >> 3) * 8;
        for (int j = lw; j < 512; j += nlw) { const int head = xcd * 2 + ((j >> 2) & 1);
            attn_item(lds + wid * 16384, (const bf16_t*)(p.ws + OFF_QKV), y, j >> 3, head, j & 3, lane);
#ifdef DUP_ATT
            attn_item(lds + wid * 16384, (const bf16_t*)(p.ws + OFF_QKV), y, j >> 3, head, j & 3, lane);
#endif
        }
    } else {
        for (int i = gwv; i < 4096; i += GW) attn_item(lds + wid * 16384, (const bf16_t*)(p.ws + OFF_QKV), y, i >> 6, (i >> 2) & 15, i & 3, lane);
    }
    E1_STAMP(2);
    if (pool_here && wid >= 4) {
        for (int i = blockIdx.x * 4 + (wid - 4), k = 0; i < 4096; i += G * 4, ++k) { const int tt = i >> 2;
            switch ((k & 1) ? 3 - (i & 3) : (i & 3)) { case 0: pool_item<2>(z, y, pwt, psc, tt, lane); break; case 1: pool_item<4>(z, y, pwt, psc, tt, lane); break; case 2: pool_item<8>(z, y, pwt, psc, tt, lane); break; default: pool_item<16>(z, y, pwt, psc, tt, lane); break; }
        }
    }
    E1_STAMP(3);
}

__device__ __forceinline__ void pool_tail_items(const Params& p, int layer, int b) {
    const bf16_t* z = (const bf16_t*)(p.ws + OFF_HID); bf16_t* y = (bf16_t*)(p.ws + OFF_Y);
    const bf16_t* pwt = (const bf16_t*)(p.ws + OFF_POOLW); const float* psc = p.in[7] + (size_t)layer * 512;
    const int tid = ltid(); const int lane = tid & 63;
    const int wid = __builtin_amdgcn_readfirstlane(tid >> 6);
    for (int i = b * 8 + wid, k = 0; i < 4096; i += 1024, ++k) { const int tt = i >> 2;
        switch ((k & 1) ? 3 - (i & 3) : (i & 3)) { case 0: pool_item<2>(z, y, pwt, psc, tt, lane); break; case 1: pool_item<4>(z, y, pwt, psc, tt, lane); break; case 2: pool_item<8>(z, y, pwt, psc, tt, lane); break; default: pool_item<16>(z, y, pwt, psc, tt, lane); break; }
    }
}

__device__ __forceinline__ void lru_final_phase(const Params& p) {
    const bf16_t* z = (const bf16_t*)(p.ws + OFF_HID); bf16_t* y = (bf16_t*)(p.ws + OFF_Y);
    const float* HL = (const float*)(p.ws + OFF_H); const float* PC = HL + (size_t)S_ * 512;
    const float* sumP = (const float*)(p.ws + OFF_LSUM); const float* sumH = sumP + 128 * 512;
    const int d = ltid();
    for (int it = blockIdx.x; it < 256; it += gridDim.x) {
        const int ck = it >> 1, t0 = it * 64;
        float hl[16], pc[16]; unsigned short gz[16];
#define E2_LOAD(TB) do { _Pragma("unroll") for (int k = 0; k < 16; ++k) { const size_t t = (size_t)(t0 + (TB) + k); hl[k] = HL[t * 512 + d]; pc[k] = PC[t * 512 + d]; gz[k] = z[t * INW_ + 1024 + d]; } } while (0)
        E2_LOAD(0);
        float carry = 0.f;
        for (int c0 = 0; c0 < ck; c0 += 64) {
            f32x4 pp[16], hq[16];
            const f32x4* sp4 = (const f32x4*)(sumP + (size_t)d * 128 + c0); const f32x4* sh4 = (const f32x4*)(sumH + (size_t)d * 128 + c0);
#pragma unroll
            for (int k = 0; k < 16; ++k) { pp[k] = sp4[k]; hq[k] = sh4[k]; }
            asm volatile("" :: "v"(pp[0]), "v"(pp[1]), "v"(pp[2]), "v"(pp[3]), "v"(pp[4]), "v"(pp[5]), "v"(pp[6]), "v"(pp[7]), "v"(pp[8]), "v"(pp[9]), "v"(pp[10]), "v"(pp[11]), "v"(pp[12]), "v"(pp[13]), "v"(pp[14]), "v"(pp[15]));
            asm volatile("" :: "v"(hq[0]), "v"(hq[1]), "v"(hq[2]), "v"(hq[3]), "v"(hq[4]), "v"(hq[5]), "v"(hq[6]), "v"(hq[7]), "v"(hq[8]), "v"(hq[9]), "v"(hq[10]), "v"(hq[11]), "v"(hq[12]), "v"(hq[13]), "v"(hq[14]), "v"(hq[15]));
#pragma unroll
            for (int k = 0; k < 16; ++k)
#pragma unroll
                for (int e = 0; e < 4; ++e) { const bool in = (c0 + k * 4 + e) < ck; carry = in ? pp[k][e] * carry + hq[k][e] : carry; }
        }
#pragma unroll 1
        for (int tb = 0; tb < 64; tb += 16) {
            if (tb) E2_LOAD(tb);
            __builtin_amdgcn_sched_barrier(0);
#pragma unroll
            for (int k = 0; k < 16; ++k) { const size_t t = (size_t)(t0 + tb + k);
                const float hv = hl[k] + pc[k] * carry;
                const float g = bf2f(gz[k]);
                const float u = 0.7978845608f * (g + 0.044715f * g * g * g);
                const float th = 1.0f - 2.0f * __builtin_amdgcn_rcpf(1.0f + __expf(2.0f * u));
                const float ge = 0.5f * g * (1.0f + th);
                y[t * D_ + 512 + d] = (bf16_t)(cvt_pk_bf16(hv * ge, 0.f) & 0xffffu); }
        }
#undef E2_LOAD
    }
}

__global__ void __launch_bounds__(512, 2) mk_fwd(Params p, int ph_lo, int ph_hi) {
    extern __shared__ __attribute__((aligned(16))) unsigned char shm[];
    LAS unsigned char* lds = (LAS unsigned char*)shm;
    cg::grid_group grid = cg::this_grid();
    unsigned char* ws = p.ws;
    volatile LAS unsigned* bst = (volatile LAS unsigned*)(lds + 131072);
    if (threadIdx.x < 4) bst[threadIdx.x] = 0u;
    __syncthreads();
    if (ph_hi - ph_lo > 1) {
        if (blockIdx.x == 0) { for (int i = threadIdx.x; i < XCD_BAR_WORDS; i += 512) __hip_atomic_store((unsigned*)(ws + OFF_BAR) + i, 0u, __ATOMIC_RELAXED, __HIP_MEMORY_SCOPE_AGENT); }
        grid.sync();
    }
    XcdBarrier bar = xcd_barrier_post((unsigned*)(ws + OFF_BAR), bst);
#ifdef PROBE_PH_A
    if (blockIdx.x == 0 && threadIdx.x == 0) __hip_atomic_store((unsigned long long*)(ws + OFF_TS), (unsigned long long)__builtin_amdgcn_s_memrealtime(), __ATOMIC_RELAXED, __HIP_MEMORY_SCOPE_AGENT);
#endif
    bf16_t* XN = (bf16_t*)(ws + OFF_XN); float* RS = (float*)(ws + OFF_RS);        bf16_t* HID = (bf16_t*)(ws + OFF_HID); bf16_t* H = (bf16_t*)(ws + OFF_H); bf16_t* Y = (bf16_t*)(ws + OFF_Y);
    for (int ph = ph_lo; ph < ph_hi; ++ph) {
#ifdef DUP_MASK
      for (int rep = 0; rep < ((ph > 0 && ((DUP_MASK >> ((ph - 1) % 11)) & 1)) ? 2 : 1); ++rep)
#endif
        if (ph == 0) {
            convert_phase(lds, p, 0);
#ifdef DUP_CONV
            convert_phase(lds, p, 0); convert_phase(lds, p, 0);
#endif
            norm_phase(nullptr, p.in[0], XN, 0.f, nullptr, RS, nullptr);
        } else {
            const int layer = (ph - 1) / 11, st = (ph - 1) % 11;
            const float* g = p.in[1] + (size_t)layer * 6 * D_;
            if (st == 0 || st == 8) {
                pg8::Gemm gm; gm.A = XN; gm.Bt = (const bf16_t*)(ws + (st == 0 ? OFF_W1IN : OFF_W2IN)); gm.M = S_; gm.N = 2 * DFF_; gm.K = D_;
                pg8::StaticOrder so; so.init(gm.M, gm.N, (int)gridDim.x, (int)blockIdx.x);
                pg8::EpiSwiGLU e; e.O = HID; e.ldc = DFF_; e.RS = RS;
                #ifndef NO_G1
                pg8::gemm_phase<pg8::EpiSwiGLU, pg8::StaticOrder, true, true>(lds, gm, so, e);
#endif
            } else if (st == 1 || st == 9 || st == 6 || st == 3) {
                pg8::Gemm gm; gm.M = S_; pg8::EpiBf16P e;
                e.QKV = nullptr; e.RS = nullptr;
                if (st == 3) { gm.A = XN; gm.Bt = (const bf16_t*)(ws + OFF_WMIN); gm.N = INW_; gm.K = D_; e.O = HID; e.ldc = INW_; e.QKV = (bf16_t*)(ws + OFF_QKV); e.RS = RS; }
                else if (st == 6) { gm.A = Y; gm.Bt = (const bf16_t*)(ws + OFF_WMOUT); gm.N = D_; gm.K = D_; e.O = H; e.ldc = D_; }
                else { gm.A = HID; gm.Bt = (const bf16_t*)(ws + (st == 1 ? OFF_W1OUT : OFF_W2OUT)); gm.N = D_; gm.K = DFF_; e.O = H; e.ldc = D_; }
                pg8::StaticOrder so; so.init(gm.M, gm.N, (int)gridDim.x, (int)blockIdx.x);
                const bool tail = (st == 3) && (gridDim.x == 256);
                for (int hf = 0; hf < (tail ? 2 : 1); ++hf) {
                    if (tail) { so.i0 = hf * 2; so.rounds = hf ? 3 : 2; }
                    pg8::gemm_phase<pg8::EpiBf16P, pg8::StaticOrder, true, true>(lds, gm, so, e);
                    if (tail && hf == 0) xcd_barrier(bar);
                }
                if (tail && blockIdx.x >= 128) pool_tail_items(p, layer, (int)blockIdx.x - 128);
            } else if (st == 2) {
                norm_phase(H, nullptr, XN, 0.5f, g + 1 * D_, RS, nullptr);
            } else if (st == 7) {
                norm_phase(H, nullptr, XN, 1.0f, g + 3 * D_, RS, nullptr);
            } else if (st == 10) {
                const bool more = (layer + 1 < DEPTH_);
                norm_phase(H, nullptr, XN, 0.5f, g + 5 * D_, RS, more ? nullptr : p.out);
                if (more) convert_phase(lds, p, layer + 1);
            } else if (st == 4) {
#ifndef NO_MIX
                mixers_phase(lds, p, layer, gridDim.x != 256);
#endif
            } else {
                lru_final_phase(p);
            }
        }
        if (ph + 1 < ph_hi) xcd_barrier(bar);
#ifdef PROBE_PH_A
        if (ph + 1 == ph_hi) xcd_barrier(bar);
        if (blockIdx.x == 0 && threadIdx.x == 0) __hip_atomic_store((unsigned long long*)(ws + OFF_TS) + ph + 1, (unsigned long long)__builtin_amdgcn_s_memrealtime(), __ATOMIC_RELAXED, __HIP_MEMORY_SCOPE_AGENT);
#endif
    }
#ifdef PROBE_PH_A
    {
        xcd_barrier(bar);
        const unsigned long long* ts = (const unsigned long long*)(ws + OFF_TS);
        const unsigned long long a0 = __hip_atomic_load(ts + PROBE_PH_A, __ATOMIC_RELAXED, __HIP_MEMORY_SCOPE_AGENT), a1 = __hip_atomic_load(ts + PROBE_PH_A + 1, __ATOMIC_RELAXED, __HIP_MEMORY_SCOPE_AGENT);
        const unsigned long long b0 = __hip_atomic_load(ts + PROBE_PH_B, __ATOMIC_RELAXED, __HIP_MEMORY_SCOPE_AGENT), b1 = __hip_atomic_load(ts + PROBE_PH_B + 1, __ATOMIC_RELAXED, __HIP_MEMORY_SCOPE_AGENT);
#ifdef PROBE_CONST
        const float dA = PROBE_CONST;
#else
#ifdef PROBE_SPAN
        const unsigned long long e1 = __hip_atomic_load(ts + PROBE_PH_A + PROBE_SPAN, __ATOMIC_RELAXED, __HIP_MEMORY_SCOPE_AGENT);
        const float dA = (float)(e1 - a0) * 0.01f * 1e-6f;
#else
        const float dA = (float)(a1 - a0) * 0.01f * 1e-5f;
#endif
#endif
        const float dB = 0.1f + (float)(b1 - b0) * 0.01f * (1.0f / 2000.0f);
        for (size_t i = (size_t)blockIdx.x * 512 + threadIdx.x; i < (size_t)S_ * D_; i += (size_t)gridDim.x * 512) p.out[i] += dA + (i == 777 ? dB : 0.f);
    }
#endif
}

#ifndef MK_COOP
#define MK_COOP 1
#endif
extern "C" void kernel_launch(void* const* d_in, const int* in_sizes, int n_in, void* d_out, int out_size, void* d_ws, size_t ws_size, hipStream_t stream) {
    static int grid_blocks = 0;
    if (!grid_blocks) {
        if (n_in != 15 || out_size != S_ * D_ || ws_size < WS_END) { fprintf(stderr, "kernel_launch: unexpected shapes (n_in %d out %d ws %zu need %zu)\n", n_in, out_size, ws_size, (size_t)WS_END); grid_blocks = -1; return; }
        int dev = 0, cus = 0, per_cu = 0;
        hipGetDevice(&dev);
        hipDeviceGetAttribute(&cus, hipDeviceAttributeMultiprocessorCount, dev);
        if (hipFuncSetAttribute((const void*)mk_fwd, hipFuncAttributeMaxDynamicSharedMemorySize, LDS_BYTES) != hipSuccess) { fprintf(stderr, "kernel_launch: hipFuncSetAttribute failed\n"); grid_blocks = -1; return; }
        hipOccupancyMaxActiveBlocksPerMultiprocessor(&per_cu, (const void*)mk_fwd, 512, LDS_BYTES);
        if (per_cu < 1) { fprintf(stderr, "kernel_launch: occupancy query says %d\n", per_cu); per_cu = 1; }
        (void)hipGetLastError();
        grid_blocks = cus * per_cu;
    }
    if (grid_blocks < 0) return;
    Params p{};
    for (int i = 0; i < 15; ++i) p.in[i] = (const float*)d_in[i];
    p.out = (float*)d_out; p.ws = (unsigned char*)d_ws;
#if MK_COOP
    int lo = 0, hi = NPHASE;
    void* args[] = {&p, &lo, &hi};
    hipError_t e = hipLaunchCooperativeKernel((const void*)mk_fwd, dim3(grid_blocks), dim3(512), args, LDS_BYTES, stream);
    if (e != hipSuccess) fprintf(stderr, "cooperative launch failed: %s (grid %d)\n", hipGetErrorString(e), grid_blocks);
#else
    for (int ph = 0; ph < NPHASE; ++ph) hipLaunchKernelGGL(mk_fwd, dim3(grid_blocks), dim3(512), LDS_BYTES, stream, p, ph, ph + 1);
#endif
}
```

```cpp
#include <hip/hip_runtime.h>
#include <hip/hip_cooperative_groups.h>
#include <cstdio>
namespace cg = cooperative_groups;
#define XB_TMO      128
#define XB_XCNT(j)  (256  + 64 * (j))
#define XB_XSUB(j)  (1280 + 64 * (j))
#define XB_XGEN(j)  (2304 + 64 * (j))
#define XB_TOP      3328
#define XB_TOPGEN   3392
#define XCD_BAR_WORDS 3456
#define XB_SPIN_CAP (1u << 18)
#define LAS __attribute__((address_space(3)))

__device__ __forceinline__ unsigned xb_ld(unsigned* p)              { return __hip_atomic_load(p, __ATOMIC_RELAXED, __HIP_MEMORY_SCOPE_AGENT); }
__device__ __forceinline__ unsigned xb_add(unsigned* p, unsigned v) { return __hip_atomic_fetch_add(p, v, __ATOMIC_RELAXED, __HIP_MEMORY_SCOPE_AGENT); }
__device__ __forceinline__ unsigned xb_xcc_id() { return (unsigned)__builtin_amdgcn_s_getreg((3 << 11) | 20) & 0xFu; }
#define XB_SPIN(cond, bar) do { unsigned _sp = 0; while (cond) { __builtin_amdgcn_s_sleep(1); \
    if ((++_sp & 255u) == 0u) { if (xb_ld(&(bar)[XB_TMO])) break; if (_sp > XB_SPIN_CAP) { atomicAdd(&(bar)[XB_TMO], 1u); break; } } } } while (0)

struct XcdBarrier {
    unsigned* bar; unsigned x;
    volatile LAS unsigned* st;
};

__device__ __forceinline__ XcdBarrier xcd_barrier_post(unsigned* bar, volatile LAS unsigned* st) {
    XcdBarrier b; b.bar = bar; b.x = xb_xcc_id(); b.st = st;
    if (threadIdx.x == 0) (void)xb_add(&bar[XB_XCNT(b.x)], 1u);
    return b;
}
__device__ __forceinline__ void xcd_barrier_complete(unsigned* bar, unsigned x, unsigned& nloc, unsigned& nx) {
    const unsigned G = gridDim.x * gridDim.y * gridDim.z;
    unsigned sum, cnt, mine, sp = 0u;
    for (;;) {
        sum = 0u; cnt = 0u; mine = 0u;
#pragma unroll
        for (unsigned j = 0; j < 16; ++j) { const unsigned c = xb_ld(&bar[XB_XCNT(j)]); sum += c; cnt += (c > 0u) ? 1u : 0u; mine = (j == x) ? c : mine; }
        if (sum == G) break;
        __builtin_amdgcn_s_sleep(1);
        if ((++sp & 255u) == 0u) { if (xb_ld(&bar[XB_TMO])) break; if (sp > XB_SPIN_CAP) { atomicAdd(&bar[XB_TMO], 1u); break; } }
    }
    nloc = mine > 0u ? mine : 1u; nx = cnt > 0u ? cnt : 1u;
}

__device__ __forceinline__ void xcd_barrier(const XcdBarrier& b) {
    asm volatile("s_waitcnt vmcnt(0)" ::: "memory");
    __syncthreads();
    if (threadIdx.x == 0) {
        unsigned* bar = b.bar;
        __builtin_amdgcn_s_waitcnt(0);
        unsigned nloc = b.st[0], nx = b.st[1];
        if (nloc == 0u) { xcd_barrier_complete(bar, b.x, nloc, nx); b.st[0] = nloc; b.st[1] = nx; }
        const unsigned old = xb_add(&bar[XB_XSUB(b.x)], 1u);
        const unsigned gen = old / nloc;
        if (old + 1u == (gen + 1u) * nloc) {
            __builtin_amdgcn_fence(__ATOMIC_RELEASE, "agent");
            asm volatile("s_waitcnt vmcnt(0)" ::: "memory");
            const unsigned og = xb_add(&bar[XB_TOP], 1u);
            const unsigned tg = og / nx;
            if (og + 1u == (tg + 1u) * nx) xb_add(&bar[XB_TOPGEN], 1u);
            else XB_SPIN(xb_ld(&bar[XB_TOPGEN]) == tg, bar);
            __builtin_amdgcn_fence(__ATOMIC_ACQUIRE, "agent");
            xb_add(&bar[XB_XGEN(b.x)], 1u);
            asm volatile("s_waitcnt vmcnt(0)" ::: "memory");
        } else {
            XB_SPIN(xb_ld(&bar[XB_XGEN(b.x)]) == gen, bar);
            __builtin_amdgcn_fence(__ATOMIC_ACQUIRE, "agent");
            asm volatile("s_waitcnt vmcnt(0)" ::: "memory");
        }
    }
    __syncthreads();
}
#include <hip/hip_runtime.h>
namespace pg8 {
#define PG8_LAS __attribute__((address_space(3)))
typedef unsigned short bf16_t;
typedef short bf16x8 __attribute__((ext_vector_type(8)));
typedef float f32x4 __attribute__((ext_vector_type(4)));
typedef unsigned u32x4 __attribute__((ext_vector_type(4)));
constexpr int BM = 256, BK = 64, HALF = 128, HTB = HALF * BK * 2  , STAGE_BYTES = 8 * HTB, NXCD = 8, WGM = 8;

__host__ __device__ __forceinline__ int lds_byte(int r, int c) { const int st = (r >> 4) * 2 + (c >> 5), rr = r & 15, cc = c & 31, ob = rr * 64 + cc * 2; return st * 1024 + (ob ^ (((ob >> 9) & 1) << 5)); }
__host__ __device__ __forceinline__ void stage_rc(int b, int& R, int& C) { const int st = b / 1024, sb = b % 1024, swz = sb ^ (((sb >> 9) & 1) << 5); R = (st >> 1) * 16 + swz / 64; C = (st & 1) * 32 + (swz % 64) / 2; }
__host__ __device__ __forceinline__ int perm32(int rho) { const int n = rho >> 4, i = rho & 15; return 8 * (i >> 2) + 4 * n + (i & 3); }

struct Unit { int pm, pn; };
struct Gemm { const bf16_t* A; const bf16_t* Bt; int M, N, K; };

struct StaticOrder {
    int nM, nN, nwg, G, c;
    __host__ __device__ void init(int M, int N, int G_, int c_) { nM = M / BM; nN = N / BM; nwg = nM * nN; G = G_; c = c_; }
    __host__ __device__ bool next(int i, Unit& u) const {
        const long L = (long)i * G + c; if (L >= nwg) return false;
        int wgid = (int)L; { const int q = nwg / NXCD, r = nwg % NXCD, xcd = wgid % NXCD, off = wgid / NXCD; wgid = (xcd < r ? xcd * (q + 1) : r * (q + 1) + (xcd - r) * q) + off; }
        const int nig = WGM * nN, gid = wgid / nig, fm = gid * WGM, gsz = (nM - fm) < WGM ? (nM - fm) : WGM;
        u.pm = fm + ((wgid % nig) % gsz); u.pn = (wgid % nig) / gsz; return true;
    }
    __device__ __forceinline__ void a_ready(const Unit&) const {}
    __device__ __forceinline__ void done(const Unit&) const {}
};
__device__ __forceinline__ unsigned cvt_pk_bf16(float lo, float hi) { unsigned r; asm volatile("v_cvt_pk_bf16_f32 %0, %1, %2" : "=v"(r) : "v"(lo), "v"(hi)); return r; }
struct EpiF32 {
    static constexpr bool PERM = false, AFTER_DRAIN = false;
    float* C; int ldc; const float* bias;
    __device__ __forceinline__ void operator()(const f32x4 (&acc)[2][2][4][2], const Unit& u, int wr, int wc, int fr, int fq) const {
        const int row0 = u.pm * BM + wr * 64 + fr, col0 = u.pn * BM + wc * 32 + 4 * fq;
        f32x4 bv[2][2];
#pragma unroll
        for (int bj = 0; bj < 2; ++bj)
#pragma unroll
            for (int n = 0; n < 2; ++n) bv[bj][n] = bias ? *(const f32x4*)(bias + col0 + bj * HALF + n * 16) : (f32x4){0.f, 0.f, 0.f, 0.f};
#pragma unroll
        for (int ai = 0; ai < 2; ++ai)
#pragma unroll
            for (int m = 0; m < 4; ++m) { float* rowp = C + (size_t)(row0 + ai * HALF + m * 16) * ldc + col0;
#pragma unroll
                for (int bj = 0; bj < 2; ++bj)
#pragma unroll
                    for (int n = 0; n < 2; ++n) *(f32x4*)(rowp + bj * HALF + n * 16) = acc[ai][bj][m][n] + bv[bj][n]; }
    }
};
typedef unsigned u32x2 __attribute__((ext_vector_type(2)));
struct EpiBf16P {
    static constexpr bool PERM = true, AFTER_DRAIN = false;
    bf16_t* O; int ldc; bf16_t* QKV; const float* RS;
    __device__ __forceinline__ void operator()(const f32x4 (&acc)[2][2][4][2], const Unit& u, int wr, int wc, int fr, int fq) const {
        const int row0 = u.pm * BM + wr * 64 + fr, col0 = u.pn * BM + wc * 32 + 8 * fq;
        const bool redir = (QKV != nullptr) && (u.pn >= 6);
        const int hd0 = (((u.pn - 6) >> 2) * 16 + ((u.pn - 6) & 3) * 4 + (wc >> 1));
        float rsv[8];
#pragma unroll
        for (int q = 0; q < 8; ++q) rsv[q] = RS ? RS[row0 + (q >> 2) * HALF + (q & 3) * 16] : 1.0f;
        if (RS) asm volatile("" :: "v"(rsv[0]), "v"(rsv[1]), "v"(rsv[2]), "v"(rsv[3]), "v"(rsv[4]), "v"(rsv[5]), "v"(rsv[6]), "v"(rsv[7]));
#pragma unroll
        for (int ai = 0; ai < 2; ++ai)
#pragma unroll
            for (int m = 0; m < 4; ++m) { const int row = row0 + ai * HALF + m * 16; const float rsc = rsv[ai * 4 + m];
                bf16_t* rowp = redir ? QKV + ((size_t)hd0 * 16384 + row) * 64 + (wc & 1) * 32 + 8 * fq : O + (size_t)row * ldc + col0;
                const size_t bjstep = redir ? (size_t)2 * 16384 * 64 : (size_t)HALF;
#pragma unroll
                for (int bj = 0; bj < 2; ++bj) { const f32x4 v0 = acc[ai][bj][m][0] * rsc, v1 = acc[ai][bj][m][1] * rsc;
                    u32x4 w; w.x = cvt_pk_bf16(v0[0], v0[1]); w.y = cvt_pk_bf16(v0[2], v0[3]); w.z = cvt_pk_bf16(v1[0], v1[1]); w.w = cvt_pk_bf16(v1[2], v1[3]);
                    *(u32x4*)(rowp + bj * bjstep) = w; } }
    }
};
__device__ __forceinline__ float silu_mul(float g, float u) { return g * u * __builtin_amdgcn_rcpf(1.0f + __expf(-g)); }
struct EpiSwiGLU {
    static constexpr bool PERM = true, AFTER_DRAIN = false;
    bf16_t* O; int ldc; const float* RS;
    __device__ __forceinline__ void operator()(const f32x4 (&acc)[2][2][4][2], const Unit& u, int wr, int wc, int fr, int fq) const {
        const int row0 = u.pm * BM + wr * 64 + fr, col0 = u.pn * HALF + wc * 32 + 8 * fq;
        float rsv[8];
#pragma unroll
        for (int q = 0; q < 8; ++q) rsv[q] = RS[row0 + (q >> 2) * HALF + (q & 3) * 16];
        asm volatile("" :: "v"(rsv[0]), "v"(rsv[1]), "v"(rsv[2]), "v"(rsv[3]), "v"(rsv[4]), "v"(rsv[5]), "v"(rsv[6]), "v"(rsv[7]));
#pragma unroll
        for (int ai = 0; ai < 2; ++ai)
#pragma unroll
            for (int m = 0; m < 4; ++m) { bf16_t* rowp = O + (size_t)(row0 + ai * HALF + m * 16) * ldc + col0; const float rsc = rsv[ai * 4 + m];
                const f32x4 g0 = acc[ai][0][m][0] * rsc, g1 = acc[ai][0][m][1] * rsc, u0 = acc[ai][1][m][0] * rsc, u1 = acc[ai][1][m][1] * rsc;
                u32x4 w; w.x = cvt_pk_bf16(silu_mul(g0[0], u0[0]), silu_mul(g0[1], u0[1])); w.y = cvt_pk_bf16(silu_mul(g0[2], u0[2]), silu_mul(g0[3], u0[3]));
                w.z = cvt_pk_bf16(silu_mul(g1[0], u1[0]), silu_mul(g1[1], u1[1])); w.w = cvt_pk_bf16(silu_mul(g1[2], u1[2]), silu_mul(g1[3], u1[3]));
                *(u32x4*)rowp = w; }
    }
};

template <class Epi, class Sched, bool ALIGN_EPI = false, bool SP2 = false>
__device__ __forceinline__ void gemm_phase(PG8_LAS unsigned char* lds, const Gemm g, const Sched& S, const Epi& E) {
    int tid_l = threadIdx.x; asm volatile("" : "+v"(tid_l));
    const int tid = tid_l, wid = __builtin_amdgcn_readfirstlane(tid >> 6), lane = tid & 63, wr = wid >> 2, wc = wid & 3, fr = lane & 15, fq = lane >> 4;
    const int K = g.K, nt = K / BK;
    unsigned voffA[2], voffB[2];
#pragma unroll
    for (int i = 0; i < 2; ++i) { int R, C; stage_rc(tid * 16 + i * 8192, R, C); const int Rb = Epi::PERM ? ((R & ~31) + perm32(R & 31)) : R;
        voffA[i] = (unsigned)(R * K + C) * 2u; voffB[i] = (unsigned)(Rb * K + C) * 2u; }
    const size_t kstep = (size_t)(BK * 2);
    const size_t hstep = (size_t)HALF * K * 2;
    const size_t tstep = 2 * hstep;
    const unsigned ldsw = (unsigned)wid * 1024u;
    const int aoff = lds_byte(wr * 64 + fr, fq * 8), boff = lds_byte(wc * 32 + fr, fq * 8);
#define PG8_SA(b, h) (((b) * 2 + (h)) * HTB)
#define PG8_SB(b, h) ((4 + (b) * 2 + (h)) * HTB)
#define PG8_STAGE(bufoff, gbase, voff) do { _Pragma("unroll") for (int _i = 0; _i < 2; ++_i) \
        __builtin_amdgcn_global_load_lds((const unsigned*)((const char*)(gbase) + (voff)[_i]), (PG8_LAS unsigned*)(lds + (bufoff) + ldsw + _i * 8192), 16, 0, 0); } while (0)
#define PG8_LDA(dst, b, h) do { _Pragma("unroll") for (int m = 0; m < 4; ++m) _Pragma("unroll") for (int k = 0; k < 2; ++k) dst[m][k] = *(const PG8_LAS bf16x8*)(lds + PG8_SA(b, h) + aoff + m * 2048 + k * 1024); } while (0)
#define PG8_LDB(dst, b, h) do { _Pragma("unroll") for (int n = 0; n < 2; ++n) _Pragma("unroll") for (int k = 0; k < 2; ++k) dst[n][k] = *(const PG8_LAS bf16x8*)(lds + PG8_SB(b, h) + boff + n * 2048 + k * 1024); } while (0)
#define PG8_MMA(ai, bj, At, Bt) do { __builtin_amdgcn_s_setprio(1); _Pragma("unroll") for (int m = 0; m < 4; ++m) _Pragma("unroll") for (int n = 0; n < 2; ++n) _Pragma("unroll") for (int k = 0; k < 2; ++k) \
        acc[ai][bj][m][n] = __builtin_amdgcn_mfma_f32_16x16x32_bf16(Bt[n][k], At[m][k], acc[ai][bj][m][n], 0, 0, 0); __builtin_amdgcn_s_setprio(0); } while (0)
#define PG8_WAIT_V(n) asm volatile("s_waitcnt vmcnt(" #n ")" ::: "memory")
#define PG8_WAIT_L(n) asm volatile("s_waitcnt lgkmcnt(" #n ")" ::: "memory")
#define PG8_BAR __builtin_amdgcn_s_barrier()
#define PG8_SCHED __builtin_amdgcn_sched_barrier(0)
    Unit cur, nxt; int ui = 0;
    if (!S.next(0, cur)) return;
    f32x4 acc[2][2][4][2];
#pragma unroll
    for (int a = 0; a < 2; ++a)
#pragma unroll
        for (int b = 0; b < 2; ++b)
#pragma unroll
            for (int m = 0; m < 4; ++m)
#pragma unroll
                for (int n = 0; n < 2; ++n) acc[a][b][m][n] = (f32x4){0.f, 0.f, 0.f, 0.f};
    bf16x8 At[4][2], B0[2][2], B1[2][2];
    const char* cA = (const char*)g.A + (size_t)cur.pm * tstep; const char* cB = (const char*)g.Bt + (size_t)cur.pn * tstep;
    S.a_ready(cur);
    if constexpr (SP2) {
        PG8_STAGE(PG8_SB(0, 0), cB, voffB); PG8_STAGE(PG8_SB(0, 1), cB + hstep, voffB); PG8_STAGE(PG8_SA(0, 0), cA, voffA); PG8_STAGE(PG8_SA(0, 1), cA + hstep, voffA);
        if (wr == 1) PG8_BAR;
        PG8_WAIT_V(2); PG8_BAR;
        PG8_STAGE(PG8_SB(1, 0), cB + kstep, voffB); PG8_STAGE(PG8_SA(1, 0), cA + kstep, voffA); PG8_STAGE(PG8_SB(1, 1), cB + hstep + kstep, voffB);
        PG8_WAIT_V(6); PG8_BAR;
    } else {
        PG8_STAGE(PG8_SB(0, 0), cB, voffB); PG8_STAGE(PG8_SA(0, 0), cA, voffA); PG8_STAGE(PG8_SB(0, 1), cB + hstep, voffB); PG8_STAGE(PG8_SA(0, 1), cA + hstep, voffA);
        if (wr == 1) PG8_BAR;
        PG8_WAIT_V(4); PG8_BAR;
        PG8_STAGE(PG8_SB(1, 0), cB + kstep, voffB); PG8_STAGE(PG8_SA(1, 0), cA + kstep, voffA); PG8_STAGE(PG8_SB(1, 1), cB + hstep + kstep, voffB);
        PG8_WAIT_V(6); PG8_BAR;
    }
    for (;;) {
        const bool has_next = S.next(ui + 1, nxt);
        const char* nA = has_next ? (const char*)g.A + (size_t)nxt.pm * tstep : cA; const char* nB = has_next ? (const char*)g.Bt + (size_t)nxt.pn * tstep : cB;
        for (int t = 0; t < nt; t += 2) {
            const bool last = (t == nt - 2);
            const char* a1 = cA + (size_t)(t + 1) * kstep;
            const char* a2 = last ? nA : cA + (size_t)(t + 2) * kstep; const char* b2 = last ? nB : cB + (size_t)(t + 2) * kstep;
            const char* a3 = a2 + kstep; const char* b3 = b2 + kstep;
            if (last && has_next) S.a_ready(nxt);
            if constexpr (SP2) {
            PG8_LDB(B0, 0, 0); PG8_LDB(B1, 0, 1); PG8_SCHED; PG8_LDA(At, 0, 0); PG8_STAGE(PG8_SA(1, 1), a1 + hstep, voffA);
            PG8_WAIT_V(8); PG8_WAIT_L(0); PG8_BAR; PG8_MMA(0, 0, At, B0); PG8_MMA(0, 1, At, B1); PG8_BAR; PG8_SCHED;
            PG8_LDA(At, 0, 1); PG8_STAGE(PG8_SB(0, 0), b2, voffB); PG8_STAGE(PG8_SB(0, 1), b2 + hstep, voffB); PG8_STAGE(PG8_SA(0, 0), a2, voffA);
            PG8_WAIT_V(8); PG8_WAIT_L(0); PG8_BAR; PG8_MMA(1, 0, At, B0); PG8_MMA(1, 1, At, B1); PG8_BAR; PG8_SCHED;
            PG8_LDB(B0, 1, 0); PG8_LDB(B1, 1, 1); PG8_SCHED; PG8_LDA(At, 1, 0); PG8_STAGE(PG8_SA(0, 1), a2 + hstep, voffA);
            PG8_WAIT_V(8); PG8_WAIT_L(0); PG8_BAR; PG8_MMA(0, 0, At, B0); PG8_MMA(0, 1, At, B1); PG8_BAR; PG8_SCHED;
            PG8_LDA(At, 1, 1); PG8_STAGE(PG8_SB(1, 0), b3, voffB); PG8_STAGE(PG8_SB(1, 1), b3 + hstep, voffB); PG8_STAGE(PG8_SA(1, 0), a3, voffA);
            PG8_WAIT_V(8); PG8_WAIT_L(0); PG8_BAR; PG8_MMA(1, 0, At, B0); PG8_MMA(1, 1, At, B1); PG8_BAR; PG8_SCHED;
            } else {
            PG8_LDB(B0, 0, 0); PG8_SCHED; PG8_LDA(At, 0, 0); PG8_STAGE(PG8_SA(1, 1), a1 + hstep, voffA);
            PG8_WAIT_L(8); PG8_BAR; PG8_WAIT_L(0); PG8_MMA(0, 0, At, B0); PG8_BAR; PG8_SCHED;
            PG8_LDB(B1, 0, 1); PG8_STAGE(PG8_SB(0, 0), b2, voffB);
            PG8_BAR; PG8_WAIT_L(0); PG8_MMA(0, 1, At, B1); PG8_BAR;
            PG8_LDA(At, 0, 1); PG8_STAGE(PG8_SA(0, 0), a2, voffA);
            PG8_BAR; PG8_WAIT_L(0); PG8_MMA(1, 0, At, B0); PG8_BAR; PG8_SCHED;
            PG8_STAGE(PG8_SB(0, 1), b2 + hstep, voffB);
            PG8_WAIT_V(6); PG8_BAR; PG8_MMA(1, 1, At, B1); PG8_BAR;
            PG8_LDB(B0, 1, 0); PG8_SCHED; PG8_LDA(At, 1, 0); PG8_STAGE(PG8_SA(0, 1), a2 + hstep, voffA);
            PG8_WAIT_L(8); PG8_BAR; PG8_WAIT_L(0); PG8_MMA(0, 0, At, B0); PG8_BAR; PG8_SCHED;
            PG8_LDB(B1, 1, 1); PG8_STAGE(PG8_SB(1, 0), b3, voffB);
            PG8_BAR; PG8_WAIT_L(0); PG8_MMA(0, 1, At, B1); PG8_BAR;
            PG8_LDA(At, 1, 1); PG8_STAGE(PG8_SA(1, 0), a3, voffA);
            PG8_BAR; PG8_WAIT_L(0); PG8_MMA(1, 0, At, B0); PG8_BAR; PG8_SCHED;
            PG8_STAGE(PG8_SB(1, 1), b3 + hstep, voffB);
            PG8_WAIT_V(6); PG8_BAR; PG8_MMA(1, 1, At, B1); PG8_BAR;
            }
        }
        if constexpr (ALIGN_EPI) { if (wr == 0) PG8_BAR; }
        if constexpr (!Epi::AFTER_DRAIN) { E(acc, cur, wr, wc, fr, fq); S.done(cur); }
        if (!has_next) break;
#pragma unroll
        for (int a = 0; a < 2; ++a)
#pragma unroll
            for (int b = 0; b < 2; ++b)
#pragma unroll
                for (int m = 0; m < 4; ++m)
#pragma unroll
                    for (int n = 0; n < 2; ++n) acc[a][b][m][n] = (f32x4){0.f, 0.f, 0.f, 0.f};
        cur = nxt; cA = nA; cB = nB; ++ui;
        if constexpr (ALIGN_EPI) { if (wr == 1) PG8_BAR; }
    }
    PG8_WAIT_V(0);
    if constexpr (!ALIGN_EPI) { if (wr == 0) PG8_BAR; }
    PG8_BAR;
    if constexpr (Epi::AFTER_DRAIN) { E.fused(acc, cur, wr, wc, fr, fq, lds, wid, lane); S.done(cur); }
#undef PG8_SA
#undef PG8_SB
#undef PG8_STAGE
#undef PG8_LDA
#undef PG8_LDB
#undef PG8_MMA
#undef PG8_WAIT_V
#undef PG8_WAIT_L
#undef PG8_BAR
#undef PG8_SCHED
}
}

using pg8::bf16_t; using pg8::bf16x8; using pg8::f32x4; using pg8::u32x4; using pg8::u32x2; using pg8::cvt_pk_bf16;

constexpr int S_ = 16384, D_ = 2048, DFF_ = 5632, INW_ = 4608, DEPTH_ = 2;
constexpr int LDS_BYTES = 131072 + 16;
constexpr size_t SZ_WIN = (size_t)2 * DFF_ * D_ * 2, SZ_WOUT = (size_t)D_ * DFF_ * 2, SZ_WMIN = (size_t)INW_ * D_ * 2, SZ_WMOUT = (size_t)D_ * D_ * 2;
constexpr size_t OFF_W1IN = 0, OFF_W1OUT = OFF_W1IN + SZ_WIN, OFF_WMIN = OFF_W1OUT + SZ_WOUT, OFF_WMOUT = OFF_WMIN + SZ_WMIN, OFF_W2IN = OFF_WMOUT + SZ_WMOUT, OFF_W2OUT = OFF_W2IN + SZ_WIN;
constexpr size_t OFF_POOLW = OFF_W2OUT + SZ_WOUT, OFF_GATEW = OFF_POOLW + 131072, OFF_LSUM = OFF_GATEW + 131072;
constexpr size_t OFF_XN = OFF_LSUM + 524288, OFF_HID = OFF_XN + (size_t)S_ * D_ * 2, OFF_H = OFF_HID + (size_t)S_ * DFF_ * 2, OFF_Y = OFF_H + (size_t)S_ * D_ * 2, OFF_BAR = OFF_Y + (size_t)S_ * D_ * 2, OFF_TS = OFF_BAR + 16384, OFF_RS = OFF_TS + 1024, OFF_QKV = OFF_RS + 65536, WS_END = OFF_QKV + (size_t)3 * 16 * S_ * 64 * 2;
constexpr int NPHASE = 1 + 11 * DEPTH_;

struct Params { const float* in[15]; float* out; unsigned char* ws; };

__device__ __forceinline__ int ltid() { int t = threadIdx.x; asm volatile("" : "+v"(t)); return t; }
__device__ __forceinline__ float bf2f(unsigned short b) { return __uint_as_float(((unsigned)b) << 16); }
__device__ __forceinline__ float wave_sum(float v) {
#pragma unroll
    for (int o = 32; o > 0; o >>= 1) v += __shfl_xor(v, o);
    return v;
}

__device__ __forceinline__ void convert_tile(LAS unsigned char* lds, const float* __restrict__ src, bf16_t* __restrict__ dst, int K, int srcN, int perm, int nt_idx, int kt_idx, int tid, const float* __restrict__ gk) {
    const int n = tid & 63, kg = tid >> 6;
    const int np0 = nt_idx * 64;
    int sc0 = np0;
    if (perm) { const int pn = np0 >> 8, bj = (np0 >> 7) & 1, j = np0 & 127; sc0 = bj * DFF_ + pn * 128 + j; }
    const float* s = src + (size_t)(kt_idx * 128 + kg * 16) * srcN + sc0 + n;
    float v[16];
#pragma unroll
    for (int i = 0; i < 16; ++i) v[i] = __builtin_nontemporal_load(s + (size_t)i * srcN);
    if (gk) {
#pragma unroll
        for (int i = 0; i < 16; ++i) v[i] *= gk[kt_idx * 128 + __builtin_amdgcn_readfirstlane(kg) * 16 + i]; }
#pragma unroll
    for (int i = 0; i < 4; ++i) { u32x2 w; w.x = cvt_pk_bf16(v[i * 4], v[i * 4 + 1]); w.y = cvt_pk_bf16(v[i * 4 + 2], v[i * 4 + 3]);
        *(LAS u32x2*)(lds + n * 264 + (kg * 4 + i) * 8) = w; }
    __syncthreads();
#pragma unroll
    for (int pass = 0; pass < 2; ++pass) { const int row = pass * 32 + (tid >> 4), c = tid & 15;
        const u32x2 a = *(const LAS u32x2*)(lds + row * 264 + c * 16), b = *(const LAS u32x2*)(lds + row * 264 + c * 16 + 8);
        u32x4 o; o.x = a.x; o.y = a.y; o.z = b.x; o.w = b.y;
        *(u32x4*)(dst + (size_t)(np0 + row) * K + kt_idx * 128 + c * 8) = o; }
    __syncthreads();
}

__device__ __forceinline__ void convert_phase(LAS unsigned char* lds, const Params& p, int layer) {
    unsigned char* ws = p.ws; const int tid = ltid();
    const int ntiles[6] = {2816, 1408, 1152, 512, 2816, 1408};
    int total = 0;
#pragma unroll
    for (int j = 0; j < 6; ++j) total += ntiles[j];
    for (int T = blockIdx.x; T < total; T += gridDim.x) {
        int loc = T; int job = 0;
#pragma unroll
        for (int j = 0; j < 5; ++j) if (job == j && loc >= ntiles[j]) { loc -= ntiles[j]; job = j + 1; }
        const float* src; bf16_t* dst; int K, srcN, perm, ntn; const float* gk = nullptr; const float* gl = p.in[1] + (size_t)layer * 6 * D_;
        switch (job) {
            case 0: src = p.in[2] + (size_t)layer * D_ * 2 * DFF_; dst = (bf16_t*)(ws + OFF_W1IN); K = D_; srcN = 2 * DFF_; perm = 1; ntn = 2 * DFF_ / 64; gk = gl; break;
            case 1: src = p.in[3] + (size_t)layer * DFF_ * D_; dst = (bf16_t*)(ws + OFF_W1OUT); K = DFF_; srcN = D_; perm = 0; ntn = D_ / 64; break;
            case 2: src = p.in[4] + (size_t)layer * D_ * INW_; dst = (bf16_t*)(ws + OFF_WMIN); K = D_; srcN = INW_; perm = 0; ntn = INW_ / 64; gk = gl + 2 * D_; break;
            case 3: src = p.in[5] + (size_t)layer * D_ * D_; dst = (bf16_t*)(ws + OFF_WMOUT); K = D_; srcN = D_; perm = 0; ntn = D_ / 64; break;
            case 4: src = p.in[13] + (size_t)layer * D_ * 2 * DFF_; dst = (bf16_t*)(ws + OFF_W2IN); K = D_; srcN = 2 * DFF_; perm = 1; ntn = 2 * DFF_ / 64; gk = gl + 4 * D_; break;
            default: src = p.in[14] + (size_t)layer * DFF_ * D_; dst = (bf16_t*)(ws + OFF_W2OUT); K = DFF_; srcN = D_; perm = 0; ntn = D_ / 64; break;
        }
        const int kt = loc / ntn, nt = loc - kt * ntn;
        convert_tile(lds, src, dst, K, srcN, perm, nt, kt, tid, gk);
    }
    const float* pw = p.in[6] + (size_t)layer * 65536; const float* gw = p.in[10] + (size_t)layer * 65536;
    bf16_t* pwt = (bf16_t*)(ws + OFF_POOLW); bf16_t* gwt = (bf16_t*)(ws + OFF_GATEW);
    for (int i = blockIdx.x * 512 + tid; i < 131072; i += gridDim.x * 512) {
        if (i < 65536) { const int g = i >> 14, d = (i >> 7) & 127, c = i & 127; pwt[i] = (bf16_t)(cvt_pk_bf16(pw[(g * 128 + c) * 128 + d], 0.f) & 0xffffu); }
        else { const int k = i - 65536; const int gh = k >> 12, d = (k >> 6) & 63, c = k & 63; gwt[k] = (bf16_t)(cvt_pk_bf16(gw[(gh * 64 + c) * 64 + d], 0.f) & 0xffffu); }
    }
}

__device__ __forceinline__ void norm_phase(const bf16_t* __restrict__ h, const float* __restrict__ xin, bf16_t* XB, float coef, const float* __restrict__ ga, float* __restrict__ RS, float* __restrict__ out) {
    const int tid = ltid(); const int lane = tid & 63, gwv = blockIdx.x * 8 + (tid >> 6), GW = gridDim.x * 8;
    for (int row0 = gwv; row0 < S_; row0 += 2 * GW) {
        const int row1 = (row0 + GW < S_) ? row0 + GW : row0;
        f32x4 xa[8], xb[8];
        if (xin) {
            const f32x4* xr0 = (const f32x4*)(xin + (size_t)row0 * D_); const f32x4* xr1 = (const f32x4*)(xin + (size_t)row1 * D_);
#pragma unroll
            for (int i = 0; i < 8; ++i) { xa[i] = xr0[lane + i * 64]; xb[i] = xr1[lane + i * 64]; }
        } else {
            const u32x2* xr0 = (const u32x2*)(XB + (size_t)row0 * D_); const u32x2* xr1 = (const u32x2*)(XB + (size_t)row1 * D_);
            u32x2 wa[8], wb[8];
#pragma unroll
            for (int i = 0; i < 8; ++i) { wa[i] = xr0[lane + i * 64]; wb[i] = xr1[lane + i * 64]; }
#pragma unroll
            for (int i = 0; i < 8; ++i) {
                xa[i] = (f32x4){__uint_as_float(wa[i].x << 16), __uint_as_float(wa[i].x & 0xffff0000u), __uint_as_float(wa[i].y << 16), __uint_as_float(wa[i].y & 0xffff0000u)};
                xb[i] = (f32x4){__uint_as_float(wb[i].x << 16), __uint_as_float(wb[i].x & 0xffff0000u), __uint_as_float(wb[i].y << 16), __uint_as_float(wb[i].y & 0xffff0000u)}; }
        }
        if (h) {
            u32x2 ha[8], hb[8];
            const u32x2* hr0 = (const u32x2*)(h + (size_t)row0 * D_); const u32x2* hr1 = (const u32x2*)(h + (size_t)row1 * D_);
#pragma unroll
            for (int i = 0; i < 8; ++i) { ha[i] = hr0[lane + i * 64]; hb[i] = hr1[lane + i * 64]; }
            float s0 = 0.f, s1 = 0.f;
#pragma unroll
            for (int i = 0; i < 8; ++i) {
                const float a0 = __uint_as_float(ha[i].x << 16), a1 = __uint_as_float(ha[i].x & 0xffff0000u), a2 = __uint_as_float(ha[i].y << 16), a3 = __uint_as_float(ha[i].y & 0xffff0000u);
                const float b0 = __uint_as_float(hb[i].x << 16), b1 = __uint_as_float(hb[i].x & 0xffff0000u), b2 = __uint_as_float(hb[i].y << 16), b3 = __uint_as_float(hb[i].y & 0xffff0000u);
                s0 += a0 * a0 + a1 * a1 + a2 * a2 + a3 * a3; s1 += b0 * b0 + b1 * b1 + b2 * b2 + b3 * b3; }
            s0 = wave_sum(s0); s1 = wave_sum(s1);
            const float r0 = coef * rsqrtf(s0 * (1.0f / D_) + 1e-6f), r1 = coef * rsqrtf(s1 * (1.0f / D_) + 1e-6f);
#pragma unroll
            for (int i = 0; i < 8; ++i) { const f32x4 g = ((const f32x4*)ga)[lane + i * 64];
                const f32x4 hva = (f32x4){__uint_as_float(ha[i].x << 16), __uint_as_float(ha[i].x & 0xffff0000u), __uint_as_float(ha[i].y << 16), __uint_as_float(ha[i].y & 0xffff0000u)};
                const f32x4 hvb = (f32x4){__uint_as_float(hb[i].x << 16), __uint_as_float(hb[i].x & 0xffff0000u), __uint_as_float(hb[i].y << 16), __uint_as_float(hb[i].y & 0xffff0000u)};
                xa[i] = xa[i] + hva * g * r0; xb[i] = xb[i] + hvb * g * r1; }
        }
        if (out) {
            f32x4* xw0 = (f32x4*)(out + (size_t)row0 * D_); f32x4* xw1 = (f32x4*)(out + (size_t)row1 * D_);
#pragma unroll
            for (int i = 0; i < 8; ++i) { xw0[lane + i * 64] = xa[i]; xw1[lane + i * 64] = xb[i]; }
        } else {
            float s0 = 0.f, s1 = 0.f;
#pragma unroll
            for (int i = 0; i < 8; ++i) { s0 += xa[i][0] * xa[i][0] + xa[i][1] * xa[i][1] + xa[i][2] * xa[i][2] + xa[i][3] * xa[i][3]; s1 += xb[i][0] * xb[i][0] + xb[i][1] * xb[i][1] + xb[i][2] * xb[i][2] + xb[i][3] * xb[i][3]; }
            s0 = wave_sum(s0); s1 = wave_sum(s1);
            if (lane == 0) { RS[row0] = rsqrtf(s0 * (1.0f / D_) + 1e-6f); RS[row1] = rsqrtf(s1 * (1.0f / D_) + 1e-6f); }
            u32x2* xo0 = (u32x2*)(XB + (size_t)row0 * D_); u32x2* xo1 = (u32x2*)(XB + (size_t)row1 * D_);
#pragma unroll
            for (int i = 0; i < 8; ++i) { u32x2 w0, w1; w0.x = cvt_pk_bf16(xa[i][0], xa[i][1]); w0.y = cvt_pk_bf16(xa[i][2], xa[i][3]); w1.x = cvt_pk_bf16(xb[i][0], xb[i][1]); w1.y = cvt_pk_bf16(xb[i][2], xb[i][3]);
                xo0[lane + i * 64] = w0; xo1[lane + i * 64] = w1; }
        }
    }
}

#define MFMA16(a, b, c) __builtin_amdgcn_mfma_f32_16x16x32_bf16((a), (b), (c), 0, 0, 0)

typedef short s16x4 __attribute__((ext_vector_type(4)));
__device__ __forceinline__ void attn_chunk_geom(int ci, int P0, int& kb, int& sh, int& ksel) {
    if (ci < 12) { sh = 0; kb = P0 - 128 + ci * 32; ksel = -1; } else if (ci < 18) { sh = 2; kb = P0 - 512 + ((ci - 12) * 32) * 4; ksel = -1; }
    else { const int k = (ci - 18) / 5, c = (ci - 18) - 5 * k; sh = 4; kb = P0 + 4 * k - 2048 + (c * 32) * 16; ksel = k; }
}
__device__ __forceinline__ void attn_load(const bf16_t* __restrict__ zk, const bf16_t* __restrict__ zv, int kb, int sh, int fr, int lane, bf16x8 (&kq)[4], bf16x8 (&vq)[4]) {
#pragma unroll
    for (int t = 0; t < 2; ++t) { int kp = kb + ((t * 16 + fr) << sh); kp = kp < 0 ? 0 : (kp > S_ - 1 ? S_ - 1 : kp);
        const bf16_t* kr = zk + (size_t)kp * 64; kq[t * 2] = *(const bf16x8*)kr; kq[t * 2 + 1] = *(const bf16x8*)(kr + 32); }
#pragma unroll
    for (int i = 0; i < 4; ++i) { int kp = kb + ((i * 8 + (lane >> 3)) << sh); kp = kp < 0 ? 0 : (kp > S_ - 1 ? S_ - 1 : kp);
        vq[i] = *(const bf16x8*)(zv + (size_t)kp * 64); }
}
__device__ __forceinline__ float xmax_16_32(float v) {
    const unsigned u = __float_as_uint(v);
    const auto r = __builtin_amdgcn_permlane16_swap(u, u, false, false);
    const float w = fmaxf(__uint_as_float(r[0]), __uint_as_float(r[1]));
    const unsigned u2 = __float_as_uint(w);
    const auto r2 = __builtin_amdgcn_permlane32_swap(u2, u2, false, false);
    return fmaxf(__uint_as_float(r2[0]), __uint_as_float(r2[1]));
}
__device__ __forceinline__ void attn_tile(const bf16x8 (&kq)[4], const bf16x8 (&vf)[4], int dbase, int sh, int lim, float nslope2, const bf16x8 qf0, const bf16x8 qf1, float& m, float& l, f32x4 (&o)[4]) {
    f32x4 st[2];
#pragma unroll
    for (int t = 0; t < 2; ++t) { st[t] = MFMA16(kq[t * 2], qf0, ((f32x4){0.f, 0.f, 0.f, 0.f})); st[t] = MFMA16(kq[t * 2 + 1], qf1, st[t]); }
    const float b0 = nslope2 * (float)dbase, bstep = nslope2 * (float)(1 << sh);
    float sv[8]; float cmax = -1e30f;
#pragma unroll
    for (int i = 0; i < 8; ++i) {
        const int c = (i >> 2) * 16 + (i & 3);
        const int delta = dbase - (c << sh);
        const float bias = b0 - bstep * (float)c;
        const float s2 = fmaf(st[i >> 2][i & 3], 0.125f * 1.44269504f, bias);
        sv[i] = ((unsigned)delta <= (unsigned)lim) ? s2 : -1e30f;
        cmax = fmaxf(cmax, sv[i]);
    }
    cmax = xmax_16_32(cmax);
    const float mn = fmaxf(m, cmax), alpha = __builtin_amdgcn_exp2f(m - mn);
    m = mn;
    float ps = 0.f; float pv[8];
#pragma unroll
    for (int i = 0; i < 8; ++i) { pv[i] = __builtin_amdgcn_exp2f(sv[i] - mn); ps += pv[i]; }
    l = l * alpha + ps;
    u32x4 pw; pw.x = cvt_pk_bf16(pv[0], pv[1]); pw.y = cvt_pk_bf16(pv[2], pv[3]); pw.z = cvt_pk_bf16(pv[4], pv[5]); pw.w = cvt_pk_bf16(pv[6], pv[7]);
    const bf16x8 pf = __builtin_bit_cast(bf16x8, pw);
#pragma unroll
    for (int dvt = 0; dvt < 4; ++dvt) { o[dvt] = o[dvt] * alpha; o[dvt] = MFMA16(vf[dvt], pf, o[dvt]); }
}
__device__ __forceinline__ void attn_chunk4(const bf16x8 (&kq)[4], const bf16x8 (&vq)[4], int kb, int sh, int ksel, LAS unsigned char* vst, LAS unsigned char* vrd, const bf16x8 (&qf)[4][2],
                                            int pq0, int fq, float slope, float (&m)[4], float (&l)[4], f32x4 (&o)[4][4]) {
#pragma unroll
    for (int i = 0; i < 4; ++i) *(LAS bf16x8*)(vst + i * 8 * 144) = vq[i];
    bf16x8 vf[4];
#pragma unroll
    for (int dvt = 0; dvt < 4; ++dvt) {
        const s16x4 lo = __builtin_amdgcn_ds_read_tr16_b64_v4i16((LAS s16x4*)(vrd + dvt * 32));
        const s16x4 hi = __builtin_amdgcn_ds_read_tr16_b64_v4i16((LAS s16x4*)(vrd + 16 * 144 + dvt * 32));
        vf[dvt] = (bf16x8){lo[0], lo[1], lo[2], lo[3], hi[0], hi[1], hi[2], hi[3]};
    }
#pragma unroll
    for (int k = 0; k < 4; ++k) if (ksel < 0 || ksel == k) { const int pq = pq0 + 4 * k, wmax = 128 << sh;
        attn_tile(kq, vf, pq - kb - ((fq * 4) << sh), sh, pq < wmax ? pq : wmax, slope, qf[k][0], qf[k][1], m[k], l[k], o[k]); }
}
__device__ __forceinline__ void attn_chunkA(const bf16x8 (&kq)[4], const bf16x8 (&vq)[4], int kb, int c, LAS unsigned char* vst, LAS unsigned char* vrd, const bf16x8 (&qf)[4][2],
                                            int pqA0, int fq, float slope, float (&m)[4], float (&l)[4], f32x4 (&o)[4][4]) {
#pragma unroll
    for (int i = 0; i < 4; ++i) *(LAS bf16x8*)(vst + i * 8 * 144) = vq[i];
    bf16x8 vf[4];
#pragma unroll
    for (int dvt = 0; dvt < 4; ++dvt) {
        const s16x4 lo = __builtin_amdgcn_ds_read_tr16_b64_v4i16((LAS s16x4*)(vrd + dvt * 32));
        const s16x4 hi = __builtin_amdgcn_ds_read_tr16_b64_v4i16((LAS s16x4*)(vrd + 16 * 144 + dvt * 32));
        vf[dvt] = (bf16x8){lo[0], lo[1], lo[2], lo[3], hi[0], hi[1], hi[2], hi[3]};
    }
#pragma unroll
    for (int t = 0; t < 4; ++t) if (c >= 2 * t && c <= 2 * t + 5) { const int pq = pqA0 + 64 * t;
        attn_tile(kq, vf, pq - kb - fq * 4, 0, pq < 128 ? pq : 128, slope, qf[t][0], qf[t][1], m[t], l[t], o[t]); }
}
__device__ __forceinline__ void attn_item(LAS unsigned char* vl, const bf16_t* __restrict__ z, bf16_t* __restrict__ y, int Bblk, int head, int rho, int lane) {
    const int fr = lane & 15, fq = lane >> 4;
    const int P0 = Bblk * 256 + rho, pq0 = P0 + 16 * fr, pqA0 = P0 + 4 * fr;
    const float slope = -1.44269504f * exp2f(-0.5f * (float)(head + 1));
    const bf16_t* zk = z + (size_t)(16 + head) * S_ * 64 + fq * 8;
    const bf16_t* zv = z + (size_t)(32 + head) * S_ * 64 + (lane & 7) * 8;
    LAS unsigned char* vst = vl + (lane >> 3) * 144 + (lane & 7) * 16;
    LAS unsigned char* vrd = vl + (fq * 4 + (fr >> 2)) * 144 + (fr & 3) * 8;
    float m[4], l[4]; f32x4 o[4][4];
#pragma unroll
    for (int k = 0; k < 4; ++k) { m[k] = -1e30f; l[k] = 0.f;
#pragma unroll
        for (int i = 0; i < 4; ++i) o[k][i] = (f32x4){0.f, 0.f, 0.f, 0.f}; }
    bf16x8 k0[4], v0[4], k1[4], v1[4];
    int kb, sh, ks, kbn, shn, ksn;
    {
        const bf16_t* zqA = z + ((size_t)head * S_ + pqA0) * 64 + fq * 8;
        bf16x8 qf[4][2];
#pragma unroll
        for (int t = 0; t < 4; ++t) { qf[t][0] = *(const bf16x8*)(zqA + t * 64 * 64); qf[t][1] = *(const bf16x8*)(zqA + t * 64 * 64 + 32); }
        attn_chunk_geom(0, P0, kb, sh, ks); attn_load(zk, zv, kb, sh, fr, lane, k0, v0);
#pragma unroll 1
        for (int c = 0; c < 12; c += 2) {
            attn_chunk_geom(c + 1, P0, kbn, shn, ksn); attn_load(zk, zv, kbn, shn, fr, lane, k1, v1);
            attn_chunk_geom(c, P0, kb, sh, ks); attn_chunkA(k0, v0, kb, c, vst, vrd, qf, pqA0, fq, slope, m, l, o);
            attn_chunk_geom(c + 2, P0, kbn, shn, ksn); attn_load(zk, zv, kbn, shn, fr, lane, k0, v0);
            attn_chunk_geom(c + 1, P0, kb, sh, ks); attn_chunkA(k1, v1, kb, c + 1, vst, vrd, qf, pqA0, fq, slope, m, l, o);
        }
    }
    {
        LAS float* rec = (LAS float*)vl;
        f32x4 o2[4][4]; float m2[4], l2[4];
        asm volatile("" ::: "memory");
#pragma unroll
        for (int h = 0; h < 2; ++h) {
#pragma unroll
            for (int t = 0; t < 4; ++t) { LAS float* w = rec + ((16 * t + fr) * 4 + fq) * 9;
#pragma unroll
                for (int e = 0; e < 4; ++e) { w[e] = o[t][2 * h][e]; w[4 + e] = o[t][2 * h + 1][e]; }
                w[8] = h ? l[t] : m[t]; }
#pragma unroll
            for (int k = 0; k < 4; ++k) { const LAS float* r = rec + ((16 * (fr >> 2) + (fr & 3) * 4 + k) * 4 + fq) * 9;
#pragma unroll
                for (int e = 0; e < 4; ++e) { o2[k][2 * h][e] = r[e]; o2[k][2 * h + 1][e] = r[4 + e]; }
                if (h) l2[k] = r[8]; else m2[k] = r[8]; }
            asm volatile("" ::: "memory");
        }
#pragma unroll
        for (int k = 0; k < 4; ++k) { m[k] = m2[k]; l[k] = l2[k];
#pragma unroll
            for (int i = 0; i < 4; ++i) o[k][i] = o2[k][i]; }
    }
    {
        const bf16_t* zq = z + ((size_t)head * S_ + pq0) * 64 + fq * 8;
        bf16x8 qf[4][2];
#pragma unroll
        for (int k = 0; k < 4; ++k) { qf[k][0] = *(const bf16x8*)(zq + k * 4 * 64); qf[k][1] = *(const bf16x8*)(zq + k * 4 * 64 + 32); }
#pragma unroll 1
        for (int ci = 12; ci < 38; ci += 2) {
            attn_chunk_geom(ci + 1, P0, kbn, shn, ksn); attn_load(zk, zv, kbn, shn, fr, lane, k1, v1);
            attn_chunk_geom(ci, P0, kb, sh, ks); attn_chunk4(k0, v0, kb, sh, ks, vst, vrd, qf, pq0, fq, slope, m, l, o);
            attn_chunk_geom(ci + 2 < 38 ? ci + 2 : 37, P0, kbn, shn, ksn); attn_load(zk, zv, kbn, shn, fr, lane, k0, v0);
            attn_chunk_geom(ci + 1, P0, kb, sh, ks); attn_chunk4(k1, v1, kb, sh, ks, vst, vrd, qf, pq0, fq, slope, m, l, o);
        }
    }
#pragma unroll
    for (int k = 0; k < 4; ++k) {
        float lk = l[k]; lk += __shfl_xor(lk, 16); lk += __shfl_xor(lk, 32);
        const float inv = 1.0f / lk;
        bf16_t* yo = y + (size_t)(pq0 + 4 * k) * D_ + 1024 + head * 64 + fq * 4;
#pragma unroll
        for (int dvt = 0; dvt < 4; ++dvt) { u32x2 w; w.x = cvt_pk_bf16(o[k][dvt][0] * inv, o[k][dvt][1] * inv); w.y = cvt_pk_bf16(o[k][dvt][2] * inv, o[k][dvt][3] * inv); *(u32x2*)(yo + dvt * 16) = w; }
    }
}

#ifndef POOL_PREF_MAX
#define POOL_PREF_MAX 16
#endif
template <int WIN> __device__ __forceinline__ void pool_load(const bf16_t* __restrict__ zc, int t, bf16x8 (&d)[WIN]) {
#pragma unroll
    for (int j = 0; j < WIN; ++j) { const int tj = t - j; d[j] = *(const bf16x8*)(zc + (size_t)(tj < 0 ? 0 : tj) * INW_); }
}
template <int WIN> __device__ __forceinline__ void pool_item(const bf16_t* __restrict__ z, bf16_t* __restrict__ y, const bf16_t* __restrict__ pwt, const float* __restrict__ scale, int item, int lane) {
    const int fr = lane & 15, fq = lane >> 4;
    constexpr int win = WIN, gi = (WIN == 2) ? 0 : (WIN == 4) ? 1 : (WIN == 8) ? 2 : 3; const int t = item * 16 + fr;
    const float invn = 1.0f / (float)((t + 1) < win ? (t + 1) : win);
    const bf16_t* wb = pwt + (size_t)gi * 16384 + fr * 128 + fq * 8;
    const bf16_t* zb = z + gi * 128 + fq * 8;
    f32x4 acc[8];
#pragma unroll
    for (int dt = 0; dt < 8; ++dt) acc[dt] = (f32x4){0.f, 0.f, 0.f, 0.f};
    constexpr bool PREF = (WIN <= POOL_PREF_MAX);
    bf16x8 zc[WIN], zn[WIN];
    pool_load<WIN>(zb, t, zc);
#pragma unroll 1
    for (int kk = 0; kk < 4; ++kk) {
        if (PREF) pool_load<WIN>(zb + (kk < 3 ? kk + 1 : 3) * 32, t, zn);
        float s[8];
#pragma unroll
        for (int e = 0; e < 8; ++e) s[e] = 0.f;
#pragma unroll
        for (int j = 0; j < win; ++j) { const float f = (t - j >= 0) ? 1.0f : 0.0f;
#pragma unroll
            for (int e = 0; e < 8; ++e) s[e] += f * bf2f((unsigned short)zc[j][e]); }
        u32x4 w;
        w.x = cvt_pk_bf16(s[0] * invn - bf2f((unsigned short)zc[0][0]), s[1] * invn - bf2f((unsigned short)zc[0][1]));
        w.y = cvt_pk_bf16(s[2] * invn - bf2f((unsigned short)zc[0][2]), s[3] * invn - bf2f((unsigned short)zc[0][3]));
        w.z = cvt_pk_bf16(s[4] * invn - bf2f((unsigned short)zc[0][4]), s[5] * invn - bf2f((unsigned short)zc[0][5]));
        w.w = cvt_pk_bf16(s[6] * invn - bf2f((unsigned short)zc[0][6]), s[7] * invn - bf2f((unsigned short)zc[0][7]));
        const bf16x8 pf = __builtin_bit_cast(bf16x8, w);
#pragma unroll
        for (int dt = 0; dt < 8; ++dt) { const bf16x8 wf = *(const bf16x8*)(wb + dt * 16 * 128 + kk * 32); acc[dt] = MFMA16(wf, pf, acc[dt]); }
        if (kk < 3) { if (PREF) {
#pragma unroll
            for (int j = 0; j < WIN; ++j) zc[j] = zn[j]; } else pool_load<WIN>(zb + (kk + 1) * 32, t, zc); }
    }
    bf16_t* yo = y + (size_t)t * D_ + gi * 128 + fq * 4;
    const float* sc = scale + gi * 128 + fq * 4;
    f32x4 s4[8];
#pragma unroll
    for (int dt = 0; dt < 8; ++dt) s4[dt] = *(const f32x4*)(sc + dt * 16);
    asm volatile("" :: "v"(s4[0]), "v"(s4[1]), "v"(s4[2]), "v"(s4[3]), "v"(s4[4]), "v"(s4[5]), "v"(s4[6]), "v"(s4[7]));
#pragma unroll
    for (int dt = 0; dt < 8; ++dt) {
        u32x2 w; w.x = cvt_pk_bf16(acc[dt][0] * s4[dt][0], acc[dt][1] * s4[dt][1]); w.y = cvt_pk_bf16(acc[dt][2] * s4[dt][2], acc[dt][3] * s4[dt][3]);
        *(u32x2*)(yo + dt * 16) = w;
    }
}

__device__ __forceinline__ void lru_item(LAS unsigned char* wlds, const bf16_t* __restrict__ z, const Params& p, int layer, const bf16_t* __restrict__ gwt,
                                         float* __restrict__ HL, float* __restrict__ PC, float* __restrict__ sumP, float* __restrict__ sumH, int item, int lane, unsigned* lru_done) {
    const int fr = lane & 15, fq = lane >> 4;
    const int hh = item & 7, ck = item >> 3, T0 = ck * 128;
    const float* convw = p.in[8] + (size_t)layer * 4 * 512 + hh * 64;
    const float* convb = p.in[9] + (size_t)layer * 512 + hh * 64;
    const float* gb = p.in[11] + (size_t)layer * 1024;
    const float* lam = p.in[12] + (size_t)layer * 512 + hh * 64;
    LAS float* Al = (LAS float*)wlds; LAS float* Gl = (LAS float*)(wlds + 4224);
    float br_[4], bi_[4], sp_[4];
#pragma unroll
    for (int nt = 0; nt < 4; ++nt) { const int d = nt * 16 + fr; br_[nt] = gb[hh * 64 + d]; bi_[nt] = gb[512 + hh * 64 + d];
        const float nl = -lam[d]; sp_[nt] = (nl > 20.f) ? nl : log1pf(__expf(nl)); }
    const float w0 = convw[lane], w1 = convw[512 + lane], w2 = convw[1024 + lane], w3 = convw[1536 + lane], cb = convb[lane];
    const bf16_t* zx = z + 512 + hh * 64;
    float xm3 = (T0 >= 3) ? bf2f(zx[(size_t)(T0 - 3) * INW_ + lane]) : 0.f, xm2 = (T0 >= 2) ? bf2f(zx[(size_t)(T0 - 2) * INW_ + lane]) : 0.f, xm1 = (T0 >= 1) ? bf2f(zx[(size_t)(T0 - 1) * INW_ + lane]) : 0.f;
    float hst = 0.f, pst = 1.f;
    bf16x8 gwr[4][2], gwi[4][2];
#pragma unroll
    for (int nt = 0; nt < 4; ++nt)
#pragma unroll
        for (int kk = 0; kk < 2; ++kk) { gwr[nt][kk] = *(const bf16x8*)(gwt + (size_t)(hh * 64 + nt * 16 + fr) * 64 + kk * 32 + fq * 8);
            gwi[nt][kk] = *(const bf16x8*)(gwt + (size_t)((8 + hh) * 64 + nt * 16 + fr) * 64 + kk * 32 + fq * 8); }
    asm volatile("" :: "v"(gwr[0][0]), "v"(gwr[0][1]), "v"(gwr[1][0]), "v"(gwr[1][1]), "v"(gwr[2][0]), "v"(gwr[2][1]), "v"(gwr[3][0]), "v"(gwr[3][1]),
                 "v"(gwi[0][0]), "v"(gwi[0][1]), "v"(gwi[1][0]), "v"(gwi[1][1]), "v"(gwi[2][0]), "v"(gwi[2][1]), "v"(gwi[3][0]), "v"(gwi[3][1]));
    LAS float* wl = (LAS float*)(wlds + 8448);
    wl[lane] = w0; wl[64 + lane] = w1; wl[128 + lane] = w2; wl[192 + lane] = w3; wl[256 + lane] = cb;
    asm volatile("s_waitcnt lgkmcnt(0)" ::: "memory");
    bf16x8 zin[2][4], znx[2][4]; unsigned short xzr[16];
#define LRU_LOAD(ZI, TT0) do { _Pragma("unroll") for (int kk = 0; kk < 2; ++kk) _Pragma("unroll") for (int tap = 0; tap < 4; ++tap) { const int tj = (TT0) + fr - 3 + tap; \
            ZI[kk][tap] = *(const bf16x8*)(zx + (size_t)(tj < 0 ? 0 : tj) * INW_ + kk * 32 + fq * 8); } } while (0)
    LRU_LOAD(zin, T0);
    for (int sub = 0; sub < 8; ++sub) {
        const int t0 = T0 + sub * 16, t = t0 + fr;
#pragma unroll
        for (int tt = 0; tt < 16; ++tt) xzr[tt] = zx[(size_t)(t0 + tt) * INW_ + lane];
        { const int tn = (sub < 7) ? t0 + 16 : t0; LRU_LOAD(znx, tn); }
        bf16x8 xf[2];
#pragma unroll
        for (int kk = 0; kk < 2; ++kk) {
            const int c0 = kk * 32 + fq * 8;
            float a[8];
            { const f32x4 b0 = *(const LAS f32x4*)(wl + 256 + c0), b1 = *(const LAS f32x4*)(wl + 256 + c0 + 4); a[0] = b0[0]; a[1] = b0[1]; a[2] = b0[2]; a[3] = b0[3]; a[4] = b1[0]; a[5] = b1[1]; a[6] = b1[2]; a[7] = b1[3]; }
#pragma unroll
            for (int tap = 0; tap < 4; ++tap) { const float f = (t - 3 + tap >= 0) ? 1.0f : 0.0f;
                const f32x4 wa = *(const LAS f32x4*)(wl + tap * 64 + c0) * f, wb = *(const LAS f32x4*)(wl + tap * 64 + c0 + 4) * f;
                const bf16x8 v = zin[kk][tap];
                a[0] += wa[0] * bf2f((unsigned short)v[0]); a[1] += wa[1] * bf2f((unsigned short)v[1]); a[2] += wa[2] * bf2f((unsigned short)v[2]); a[3] += wa[3] * bf2f((unsigned short)v[3]);
                a[4] += wb[0] * bf2f((unsigned short)v[4]); a[5] += wb[1] * bf2f((unsigned short)v[5]); a[6] += wb[2] * bf2f((unsigned short)v[6]); a[7] += wb[3] * bf2f((unsigned short)v[7]); }
            u32x4 w; w.x = cvt_pk_bf16(a[0], a[1]); w.y = cvt_pk_bf16(a[2], a[3]); w.z = cvt_pk_bf16(a[4], a[5]); w.w = cvt_pk_bf16(a[6], a[7]);
            xf[kk] = __builtin_bit_cast(bf16x8, w);
        }
#pragma unroll
        for (int nt = 0; nt < 4; ++nt) {
            f32x4 ar = (f32x4){0.f, 0.f, 0.f, 0.f}, ai = (f32x4){0.f, 0.f, 0.f, 0.f};
#pragma unroll
            for (int kk = 0; kk < 2; ++kk) {
                ar = MFMA16(xf[kk], gwr[nt][kk], ar); ai = MFMA16(xf[kk], gwi[nt][kk], ai);
            }
#pragma unroll
            for (int j = 0; j < 4; ++j) {
                const float rg = __builtin_amdgcn_rcpf(1.0f + __expf(-(ar[j] + br_[nt]))), ig = __builtin_amdgcn_rcpf(1.0f + __expf(-(ai[j] + bi_[nt])));
                const float la = -8.0f * rg * sp_[nt];
                const float av = __expf(la), gu = sqrtf(fmaxf(1.0f - av * av, 0.f)) * ig;
                Al[(fq * 4 + j) * 66 + nt * 16 + fr] = av; Gl[(fq * 4 + j) * 66 + nt * 16 + fr] = gu;
            }
        }
        asm volatile("s_waitcnt lgkmcnt(0)" ::: "memory");
        float avv[16], guv[16];
#pragma unroll
        for (int tt = 0; tt < 16; ++tt) { avv[tt] = Al[tt * 66 + lane]; guv[tt] = Gl[tt * 66 + lane]; }
        asm volatile("s_waitcnt lgkmcnt(0)" ::: "memory");
#pragma unroll
        for (int tt = 0; tt < 16; ++tt) {
            const float xv = bf2f(xzr[tt]);
            const float xc = cb + w0 * xm3 + w1 * xm2 + w2 * xm1 + w3 * xv;
            xm3 = xm2; xm2 = xm1; xm1 = xv;
            const float av = avv[tt], gu = guv[tt];
            hst = av * hst + gu * xc; pst = pst * av;
            __hip_atomic_store(&HL[(size_t)(t0 + tt) * 512 + hh * 64 + lane], hst, __ATOMIC_RELAXED, __HIP_MEMORY_SCOPE_AGENT);
            __hip_atomic_store(&PC[(size_t)(t0 + tt) * 512 + hh * 64 + lane], pst, __ATOMIC_RELAXED, __HIP_MEMORY_SCOPE_AGENT);
        }
        asm volatile("s_waitcnt lgkmcnt(0)" ::: "memory");
#pragma unroll
        for (int kk = 0; kk < 2; ++kk)
#pragma unroll
            for (int tap = 0; tap < 4; ++tap) zin[kk][tap] = znx[kk][tap];
    }
#undef LRU_LOAD
    __hip_atomic_store(&sumP[(hh * 64 + lane) * 128 + ck], pst, __ATOMIC_RELAXED, __HIP_MEMORY_SCOPE_AGENT);
    __hip_atomic_store(&sumH[(hh * 64 + lane) * 128 + ck], hst, __ATOMIC_RELAXED, __HIP_MEMORY_SCOPE_AGENT);
    asm volatile("s_waitcnt vmcnt(0)" ::: "memory");
    if (lane == 0) __hip_atomic_fetch_add(lru_done, 1u, __ATOMIC_RELAXED, __HIP_MEMORY_SCOPE_AGENT);
}

__device__ __forceinline__ void lru_final_phase(const Params& p);
__device__ __forceinline__ void mixers_phase(LAS unsigned char* lds, const Params& p, int layer) {
    const bf16_t* z = (const bf16_t*)(p.ws + OFF_HID); bf16_t* y = (bf16_t*)(p.ws + OFF_Y);
    float* HL = (float*)(p.ws + OFF_H); float* PC = HL + (size_t)S_ * 512;
    float* sumP = (float*)(p.ws + OFF_LSUM); float* sumH = sumP + 128 * 512;
    const int tid = ltid(); const int lane = tid & 63;
    const int wid = __builtin_amdgcn_readfirstlane(tid >> 6);
    const int gwv = blockIdx.x * 8 + wid, GW = gridDim.x * 8;
    const bf16_t* pwt = (const bf16_t*)(p.ws + OFF_POOLW); const float* psc = p.in[7] + (size_t)layer * 512;
    const int G = gridDim.x;
#ifdef PROBE_PH_A
#define E1_STAMP(K) do { if (blockIdx.x == 0 && tid == 0 && layer == 0) __hip_atomic_store((unsigned long long*)(p.ws + OFF_TS) + 40 + (K), (unsigned long long)__builtin_amdgcn_s_memrealtime(), __ATOMIC_RELAXED, __HIP_MEMORY_SCOPE_AGENT); } while (0)
#else
#define E1_STAMP(K) do {} while (0)
#endif
    E1_STAMP(0);
    for (int i = blockIdx.x * 4 + wid; i < 1024; i += G * 4) {
        if (wid < 4) lru_item(lds + wid * 16384, z, p, layer, (const bf16_t*)(p.ws + OFF_GATEW), HL, PC, sumP, sumH, i, lane, (unsigned*)(p.ws + OFF_BAR) + 3968);
#ifdef DUP_LRU
        if (wid < 4) lru_item(lds + wid * 16384, z, p, layer, (const bf16_t*)(p.ws + OFF_GATEW), HL, PC, sumP, sumH, i, lane, (unsigned*)(p.ws + OFF_BAR) + 3968);
#endif
    }
    E1_STAMP(1);
    if ((G & 7) == 0) {
        const int xcd = blockIdx.x & 7, lw = (blockIdx.x >> 3) * 8 + wid, nlw = (G >> 3) * 8;
        for (int j = lw; j < 512; j += nlw) { const int head = xcd * 2 + ((j >> 2) & 1);
            attn_item(lds + wid * 16384, (const bf16_t*)(p.ws + OFF_QKV), y, j >> 3, head, j & 3, lane);
#ifdef DUP_ATT
            attn_item(lds + wid * 16384, (const bf16_t*)(p.ws + OFF_QKV), y, j >> 3, head, j & 3, lane);
#endif
        }
    } else {
        for (int i = gwv; i < 4096; i += GW) attn_item(lds + wid * 16384, (const bf16_t*)(p.ws + OFF_QKV), y, i >> 6, (i >> 2) & 15, i & 3, lane);
    }
    E1_STAMP(2);
    if (wid >= 4) {
        for (int i = blockIdx.x * 4 + (wid - 4), k = 0; i < 4096; i += G * 4, ++k) { const int tt = i >> 2;
            switch ((k & 1) ? 3 - (i & 3) : (i & 3)) { case 0: pool_item<2>(z, y, pwt, psc, tt, lane); break; case 1: pool_item<4>(z, y, pwt, psc, tt, lane); break; case 2: pool_item<8>(z, y, pwt, psc, tt, lane); break; default: pool_item<16>(z, y, pwt, psc, tt, lane); break; }
        }
    }
    E1_STAMP(3);
    __syncthreads();
    if (tid == 0) {
        unsigned* cnt = (unsigned*)(p.ws + OFF_BAR) + 3968; const unsigned target = 1024u * (unsigned)(layer + 1); unsigned sp = 0u;
        while (__hip_atomic_load(cnt, __ATOMIC_RELAXED, __HIP_MEMORY_SCOPE_AGENT) < target) { __builtin_amdgcn_s_sleep(2); if (++sp > (1u << 20)) break; }
        __builtin_amdgcn_fence(__ATOMIC_ACQUIRE, "agent");
        asm volatile("s_waitcnt vmcnt(0)" ::: "memory");
    }
    __syncthreads();
    lru_final_phase(p);
}

__device__ __forceinline__ void lru_final_phase(const Params& p) {
    const bf16_t* z = (const bf16_t*)(p.ws + OFF_HID); bf16_t* y = (bf16_t*)(p.ws + OFF_Y);
    const float* HL = (const float*)(p.ws + OFF_H); const float* PC = HL + (size_t)S_ * 512;
    const float* sumP = (const float*)(p.ws + OFF_LSUM); const float* sumH = sumP + 128 * 512;
    const int d = ltid();
    for (int it = blockIdx.x; it < 256; it += gridDim.x) {
        const int ck = it >> 1, t0 = it * 64;
        float hl[16], pc[16]; unsigned short gz[16];
#define E2_LOAD(TB) do { _Pragma("unroll") for (int k = 0; k < 16; ++k) { const size_t t = (size_t)(t0 + (TB) + k); hl[k] = HL[t * 512 + d]; pc[k] = PC[t * 512 + d]; gz[k] = z[t * INW_ + 1024 + d]; } } while (0)
        E2_LOAD(0);
        float carry = 0.f;
        for (int c0 = 0; c0 < ck; c0 += 64) {
            f32x4 pp[16], hq[16];
            const f32x4* sp4 = (const f32x4*)(sumP + (size_t)d * 128 + c0); const f32x4* sh4 = (const f32x4*)(sumH + (size_t)d * 128 + c0);
#pragma unroll
            for (int k = 0; k < 16; ++k) { pp[k] = sp4[k]; hq[k] = sh4[k]; }
            asm volatile("" :: "v"(pp[0]), "v"(pp[1]), "v"(pp[2]), "v"(pp[3]), "v"(pp[4]), "v"(pp[5]), "v"(pp[6]), "v"(pp[7]), "v"(pp[8]), "v"(pp[9]), "v"(pp[10]), "v"(pp[11]), "v"(pp[12]), "v"(pp[13]), "v"(pp[14]), "v"(pp[15]));
            asm volatile("" :: "v"(hq[0]), "v"(hq[1]), "v"(hq[2]), "v"(hq[3]), "v"(hq[4]), "v"(hq[5]), "v"(hq[6]), "v"(hq[7]), "v"(hq[8]), "v"(hq[9]), "v"(hq[10]), "v"(hq[11]), "v"(hq[12]), "v"(hq[13]), "v"(hq[14]), "v"(hq[15]));
#pragma unroll
            for (int k = 0; k < 16; ++k)
#pragma unroll
                for (int e = 0; e < 4; ++e) { const bool in = (c0 + k * 4 + e) < ck; carry = in ? pp[k][e] * carry + hq[k][e] : carry; }
        }
#pragma unroll 1
        for (int tb = 0; tb < 64; tb += 16) {
            if (tb) E2_LOAD(tb);
            __builtin_amdgcn_sched_barrier(0);
#pragma unroll
            for (int k = 0; k < 16; ++k) { const size_t t = (size_t)(t0 + tb + k);
                const float hv = hl[k] + pc[k] * carry;
                const float g = bf2f(gz[k]);
                const float u = 0.7978845608f * (g + 0.044715f * g * g * g);
                const float th = 1.0f - 2.0f * __builtin_amdgcn_rcpf(1.0f + __expf(2.0f * u));
                const float ge = 0.5f * g * (1.0f + th);
                y[t * D_ + 512 + d] = (bf16_t)(cvt_pk_bf16(hv * ge, 0.f) & 0xffffu); }
        }
#undef E2_LOAD
    }
}

__global__ void __launch_bounds__(512, 2) mk_fwd(Params p, int ph_lo, int ph_hi) {
    extern __shared__ __attribute__((aligned(16))) unsigned char shm[];
    LAS unsigned char* lds = (LAS unsigned char*)shm;
    cg::grid_group grid = cg::this_grid();
    unsigned char* ws = p.ws;
    volatile LAS unsigned* bst = (volatile LAS unsigned*)(lds + 131072);
    if (threadIdx.x < 4) bst[threadIdx.x] = 0u;
    __syncthreads();
    if (ph_hi - ph_lo > 1) {
        if (blockIdx.x == 0) { for (int i = threadIdx.x; i < 4096; i += 512) __hip_atomic_store((unsigned*)(ws + OFF_BAR) + i, 0u, __ATOMIC_RELAXED, __HIP_MEMORY_SCOPE_AGENT); }
        grid.sync();
    }
    XcdBarrier bar = xcd_barrier_post((unsigned*)(ws + OFF_BAR), bst);
#ifdef PROBE_PH_A
    if (blockIdx.x == 0 && threadIdx.x == 0) __hip_atomic_store((unsigned long long*)(ws + OFF_TS), (unsigned long long)__builtin_amdgcn_s_memrealtime(), __ATOMIC_RELAXED, __HIP_MEMORY_SCOPE_AGENT);
#endif
    bf16_t* XN = (bf16_t*)(ws + OFF_XN); float* RS = (float*)(ws + OFF_RS);        bf16_t* HID = (bf16_t*)(ws + OFF_HID); bf16_t* H = (bf16_t*)(ws + OFF_H); bf16_t* Y = (bf16_t*)(ws + OFF_Y);
    for (int ph = ph_lo; ph < ph_hi; ++ph) {
#ifdef DUP_MASK
      for (int rep = 0; rep < ((ph > 0 && ((DUP_MASK >> ((ph - 1) % 11)) & 1)) ? 2 : 1); ++rep)
#endif
        if (ph == 0) {
            convert_phase(lds, p, 0);
#ifdef DUP_CONV
            convert_phase(lds, p, 0); convert_phase(lds, p, 0);
#endif
            norm_phase(nullptr, p.in[0], XN, 0.f, nullptr, RS, nullptr);
        } else {
            const int layer = (ph - 1) / 11, st = (ph - 1) % 11;
            const float* g = p.in[1] + (size_t)layer * 6 * D_;
            if (st == 0 || st == 8) {
                pg8::Gemm gm; gm.A = XN; gm.Bt = (const bf16_t*)(ws + (st == 0 ? OFF_W1IN : OFF_W2IN)); gm.M = S_; gm.N = 2 * DFF_; gm.K = D_;
                pg8::StaticOrder so; so.init(gm.M, gm.N, (int)gridDim.x, (int)blockIdx.x);
                pg8::EpiSwiGLU e; e.O = HID; e.ldc = DFF_; e.RS = RS;
                #ifndef NO_G1
                pg8::gemm_phase<pg8::EpiSwiGLU, pg8::StaticOrder, true, true>(lds, gm, so, e);
#endif
            } else if (st == 1 || st == 9 || st == 6 || st == 3) {
                pg8::Gemm gm; gm.M = S_; pg8::EpiBf16P e;
                e.QKV = nullptr; e.RS = nullptr;
                if (st == 3) { gm.A = XN; gm.Bt = (const bf16_t*)(ws + OFF_WMIN); gm.N = INW_; gm.K = D_; e.O = HID; e.ldc = INW_; e.QKV = (bf16_t*)(ws + OFF_QKV); e.RS = RS; }
                else if (st == 6) { gm.A = Y; gm.Bt = (const bf16_t*)(ws + OFF_WMOUT); gm.N = D_; gm.K = D_; e.O = H; e.ldc = D_; }
                else { gm.A = HID; gm.Bt = (const bf16_t*)(ws + (st == 1 ? OFF_W1OUT : OFF_W2OUT)); gm.N = D_; gm.K = DFF_; e.O = H; e.ldc = D_; }
                pg8::StaticOrder so; so.init(gm.M, gm.N, (int)gridDim.x, (int)blockIdx.x);
                pg8::gemm_phase<pg8::EpiBf16P, pg8::StaticOrder, true, true>(lds, gm, so, e);
            } else if (st == 2) {
                norm_phase(H, nullptr, XN, 0.5f, g + 1 * D_, RS, nullptr);
            } else if (st == 7) {
                norm_phase(H, nullptr, XN, 1.0f, g + 3 * D_, RS, nullptr);
            } else if (st == 10) {
                const bool more = (layer + 1 < DEPTH_);
                norm_phase(H, nullptr, XN, 0.5f, g + 5 * D_, RS, more ? nullptr : p.out);
                if (more) convert_phase(lds, p, layer + 1);
            } else if (st == 4) {
#ifndef NO_MIX
                mixers_phase(lds, p, layer);
#endif
            } else {
            }
        }
        if (ph + 1 < ph_hi && !(ph > 0 && (ph - 1) % 11 == 4)) xcd_barrier(bar);
#ifdef PROBE_PH_A
        if (ph + 1 == ph_hi) xcd_barrier(bar);
        if (blockIdx.x == 0 && threadIdx.x == 0) __hip_atomic_store((unsigned long long*)(ws + OFF_TS) + ph + 1, (unsigned long long)__builtin_amdgcn_s_memrealtime(), __ATOMIC_RELAXED, __HIP_MEMORY_SCOPE_AGENT);
#endif
    }
#ifdef PROBE_PH_A
    {
        xcd_barrier(bar);
        const unsigned long long* ts = (const unsigned long long*)(ws + OFF_TS);
        const unsigned long long a0 = __hip_atomic_load(ts + PROBE_PH_A, __ATOMIC_RELAXED, __HIP_MEMORY_SCOPE_AGENT), a1 = __hip_atomic_load(ts + PROBE_PH_A + 1, __ATOMIC_RELAXED, __HIP_MEMORY_SCOPE_AGENT);
        const unsigned long long b0 = __hip_atomic_load(ts + PROBE_PH_B, __ATOMIC_RELAXED, __HIP_MEMORY_SCOPE_AGENT), b1 = __hip_atomic_load(ts + PROBE_PH_B + 1, __ATOMIC_RELAXED, __HIP_MEMORY_SCOPE_AGENT);
#ifdef PROBE_CONST
        const float dA = PROBE_CONST;
#else
#ifdef PROBE_SPAN
        const unsigned long long e1 = __hip_atomic_load(ts + PROBE_PH_A + PROBE_SPAN, __ATOMIC_RELAXED, __HIP_MEMORY_SCOPE_AGENT);
        const float dA = (float)(e1 - a0) * 0.01f * 1e-6f;
#else
        const float dA = (float)(a1 - a0) * 0.01f * 1e-5f;
#endif
#endif
        const float dB = 0.1f + (float)(b1 - b0) * 0.01f * (1.0f / 2000.0f);
        for (size_t i = (size_t)blockIdx.x * 512 + threadIdx.x; i < (size_t)S_ * D_; i += (size_t)gridDim.x * 512) p.out[i] += dA + (i == 777 ? dB : 0.f);
    }
#endif
}

#ifndef MK_COOP
#define MK_COOP 1
#endif
extern "C" void kernel_launch(void* const* d_in, const int* in_sizes, int n_in, void* d_out, int out_size, void* d_ws, size_t ws_size, hipStream_t stream) {
    static int grid_blocks = 0;
    if (!grid_blocks) {
        if (n_in != 15 || out_size != S_ * D_ || ws_size < WS_END) { fprintf(stderr, "kernel_launch: unexpected shapes (n_in %d out %d ws %zu need %zu)\n", n_in, out_size, ws_size, (size_t)WS_END); grid_blocks = -1; return; }
        int dev = 0, cus = 0, per_cu = 0;
        hipGetDevice(&dev);
        hipDeviceGetAttribute(&cus, hipDeviceAttributeMultiprocessorCount, dev);
        if (hipFuncSetAttribute((const void*)mk_fwd, hipFuncAttributeMaxDynamicSharedMemorySize, LDS_BYTES) != hipSuccess) { fprintf(stderr, "kernel_launch: hipFuncSetAttribute failed\n"); grid_blocks = -1; return; }
        hipOccupancyMaxActiveBlocksPerMultiprocessor(&per_cu, (const void*)mk_fwd, 512, LDS_BYTES);
        if (per_cu < 1) { fprintf(stderr, "kernel_launch: occupancy query says %d\n", per_cu); per_cu = 1; }
        (void)hipGetLastError();
        grid_blocks = cus * per_cu;
    }
    if (grid_blocks < 0) return;
    Params p{};
    for (int i = 0; i < 15; ++i) p.in[i] = (const float*)d_in[i];
    p.out = (float*)d_out; p.ws = (unsigned char*)d_ws;
#if MK_COOP
    int lo = 0, hi = NPHASE;
    void* args[] = {&p, &lo, &hi};
    hipError_t e = hipLaunchCooperativeKernel((const void*)mk_fwd, dim3(grid_blocks), dim3(512), args, LDS_BYTES, stream);
    if (e != hipSuccess) fprintf(stderr, "cooperative launch failed: %s (grid %d)\n", hipGetErrorString(e), grid_blocks);
#else
    for (int ph = 0; ph < NPHASE; ++ph) hipLaunchKernelGGL(mk_fwd, dim3(grid_blocks), dim3(512), LDS_BYTES, stream, p, ph, ph + 1);
#endif
}
```
